# Optimizing an MI355X kernel written in HIP

```python
import jax, jax.numpy as jnp
from jax import lax
import numpy as np

D_MODEL = 1024
BATCH = 1
SEQ = 16384
DEPTH = 1
DEC_BATCH = 16
DEC_SEQ = 2048
PAST_LEN = 128

HEAD_DIM = 64
M_HEADS = 8
M_WIDTH = M_HEADS * HEAD_DIM
A_HEADS = 8
A_KV_HEADS = 2
A_WIDTH = A_HEADS * HEAD_DIM
KV_WIDTH = A_KV_HEADS * HEAD_DIM
MIX_WIDTH = M_WIDTH + A_WIDTH
N_GATES = 4 * M_HEADS
IN_COLS = 4 * M_WIDTH + N_GATES + A_WIDTH + 2 * KV_WIDTH
D_FF = 2816
CONV_W = 3
GRID_W = 64
CHUNK = 64
Q_BLOCK = 128
ROPE_THETA = 10000.0
EPS = 1e-6

kernel_name = "hybrid_mlstm_gqa_convffn_encoder"


def rmsnorm(x, w):
    xf = x.astype(jnp.float32)
    y = xf * lax.rsqrt(jnp.mean(xf * xf, axis=-1, keepdims=True) + EPS)
    return (y * w.astype(jnp.float32)).astype(x.dtype)


def mlstm_scan(q, k, v, ig, fg):
    B, H, T, d = q.shape
    nc = T // CHUNK
    logf = jax.nn.log_sigmoid(fg)

    def to_chunks(a):
        a = a.reshape((B, H, nc, CHUNK) + a.shape[3:])
        return jnp.moveaxis(a, 2, 0)

    qc, kc, vc, ic, fc = (to_chunks(a) for a in (q, k, v, ig, logf))
    causal = jnp.tril(jnp.ones((CHUNK, CHUNK), dtype=bool))

    def step(carry, inp):
        C, n, m = carry
        qb, kb, vb, ib, fb = inp
        b = jnp.cumsum(fb, axis=-1)
        Dm = b[..., :, None] - b[..., None, :] + ib[..., None, :]
        Dm = jnp.where(causal, Dm, -jnp.inf)
        inter = b + m[..., None]
        m_t = jnp.maximum(inter, jnp.max(Dm, axis=-1))
        Dw = jnp.exp(Dm - m_t[..., None])
        iw = jnp.exp(inter - m_t)
        s = jnp.einsum('bhld,bhsd->bhls', qb, kb) * Dw
        num = iw[..., None] * jnp.einsum('bhld,bhde->bhle', qb, C) + jnp.einsum('bhls,bhse->bhle', s, vb)
        den = iw * jnp.einsum('bhld,bhd->bhl', qb, n) + jnp.sum(s, axis=-1)
        h = num / jnp.maximum(jnp.abs(den), jnp.exp(-m_t))[..., None]
        bL = b[..., -1]
        wend = bL[..., None] - b + ib
        m_new = jnp.maximum(bL + m, jnp.max(wend, axis=-1))
        dec = jnp.exp(bL + m - m_new)
        we = jnp.exp(wend - m_new[..., None])
        C_new = dec[..., None, None] * C + jnp.einsum('bhs,bhsd,bhse->bhde', we, kb, vb)
        n_new = dec[..., None] * n + jnp.einsum('bhs,bhsd->bhd', we, kb)
        return (C_new, n_new, m_new), h

    init = (jnp.zeros((B, H, d, d), jnp.float32), jnp.zeros((B, H, d), jnp.float32),
            jnp.zeros((B, H), jnp.float32))
    _, hs = lax.scan(step, init, (qc, kc, vc, ic, fc))
    return jnp.moveaxis(hs, 0, 2).reshape(B, H, T, d)


def mlstm_mixer(mq, mk, mv, mo, gates, b_gates, mh_norm_w):
    B, T, _ = mq.shape

    def heads(a):
        return a.reshape(B, T, M_HEADS, HEAD_DIM).transpose(0, 2, 1, 3).astype(jnp.float32)

    q = heads(mq)
    k = heads(mk) * (HEAD_DIM ** -0.5)
    v = heads(mv)
    g = (gates.astype(jnp.float32) + b_gates.astype(jnp.float32)).transpose(0, 2, 1)
    i_f, i_b, f_f, f_b = jnp.split(g, 4, axis=1)
    h_f = mlstm_scan(q, k, v, i_f, f_f)
    fl = lambda a: jnp.flip(a, axis=2)
    h_b = fl(mlstm_scan(fl(q), fl(k), fl(v), fl(i_b), fl(f_b)))
    h = h_f + h_b
    h = h * lax.rsqrt(jnp.mean(h * h, axis=-1, keepdims=True) + EPS)
    h = h * mh_norm_w.astype(jnp.float32).reshape(M_HEADS, 1, HEAD_DIM)
    h = h.transpose(0, 2, 1, 3).reshape(B, T, M_WIDTH)
    return (jax.nn.sigmoid(mo.astype(jnp.float32)) * h).astype(mq.dtype)


def axial_rope_tables(T):
    rows = T // GRID_W
    row = jnp.repeat(jnp.arange(rows, dtype=jnp.float32), GRID_W)
    col = jnp.tile(jnp.arange(GRID_W, dtype=jnp.float32), rows)
    nf = HEAD_DIM // 4
    inv = ROPE_THETA ** (-jnp.arange(nf, dtype=jnp.float32) / nf)
    ar = row[:, None] * inv
    ac = col[:, None] * inv
    ang = jnp.concatenate([ar, ar, ac, ac], axis=-1)
    return jnp.cos(ang), jnp.sin(ang)


def apply_rope(x, cos, sin):
    x1r, x2r, x1c, x2c = jnp.split(x, 4, axis=-1)
    rot = jnp.concatenate([-x2r, x1r, -x2c, x1c], axis=-1)
    return (x.astype(jnp.float32) * cos + rot.astype(jnp.float32) * sin).astype(x.dtype)


def attention_mixer(aq, ak, av, q_norm_w, k_norm_w):
    B, T, _ = aq.shape
    G = A_HEADS // A_KV_HEADS
    q = rmsnorm(aq.reshape(B, T, A_KV_HEADS, G, HEAD_DIM), q_norm_w)
    k = rmsnorm(ak.reshape(B, T, A_KV_HEADS, HEAD_DIM), k_norm_w)
    v = av.reshape(B, T, A_KV_HEADS, HEAD_DIM)
    cos, sin = axial_rope_tables(T)
    q = apply_rope(q, cos[None, :, None, None], sin[None, :, None, None])
    k = apply_rope(k, cos[None, :, None], sin[None, :, None])
    nb = T // Q_BLOCK
    qb = q.reshape(B, nb, Q_BLOCK, A_KV_HEADS, G, HEAD_DIM).transpose(1, 0, 2, 3, 4, 5)
    scale = HEAD_DIM ** -0.5

    def block(qi):
        s = jnp.einsum('bqhgd,bkhd->bhgqk', qi, k).astype(jnp.float32) * scale
        p = jax.nn.softmax(s, axis=-1)
        return jnp.einsum('bhgqk,bkhd->bqhgd', p.astype(v.dtype), v)

    o = lax.map(block, qb)
    return o.transpose(1, 0, 2, 3, 4, 5).reshape(B, T, A_WIDTH)


def centred_dwconv(u, w, b):
    up = jnp.pad(u, ((0, 0), (1, 1), (0, 0)))
    return up[:, :-2] * w[0] + up[:, 1:-1] * w[1] + up[:, 2:] * w[2] + b


def encoder_layer(x, w_in, b_gates, mh_norm_w, q_norm_w, k_norm_w, w_out, norm1_w, norm2_w,
                  w_up, conv_w, conv_b, w_down):
    h = rmsnorm(x, norm1_w)
    p = h @ w_in
    cuts = np.cumsum([M_WIDTH, M_WIDTH, M_WIDTH, M_WIDTH, N_GATES, A_WIDTH, KV_WIDTH]).tolist()
    mq, mk, mv, mo, gates, aq, ak, av = jnp.split(p, cuts, axis=-1)
    m_out = mlstm_mixer(mq, mk, mv, mo, gates, b_gates, mh_norm_w)
    a_out = attention_mixer(aq, ak, av, q_norm_w, k_norm_w)
    x = x + jnp.concatenate([m_out, a_out], axis=-1) @ w_out
    h = rmsnorm(x, norm2_w)
    u = centred_dwconv(h @ w_up, conv_w, conv_b)
    a, g = jnp.split(u, 2, axis=-1)
    return x + (jax.nn.silu(g) * a) @ w_down


def run_trunk(x, w_in, b_gates, mh_norm_w, q_norm_w, k_norm_w, w_out, norm1_w, norm2_w,
              w_up, conv_w, conv_b, w_down, final_norm_w):
    for l in range(DEPTH):
        x = encoder_layer(x, w_in[l], b_gates[l], mh_norm_w[l], q_norm_w[l], k_norm_w[l], w_out[l],
                          norm1_w[l], norm2_w[l], w_up[l], conv_w[l], conv_b[l], w_down[l])
    return rmsnorm(x, final_norm_w)


def setup_inputs(seed: int = 0) -> dict:
    key = jax.random.key(seed)
    ks = jax.random.split(key, 20)
    nrm = jax.random.normal
    f32 = jnp.float32
    forget_bias = jnp.tile(jnp.linspace(3.0, 6.0, M_HEADS, dtype=f32), 2)
    b_gates = jnp.concatenate([
        0.1 * nrm(ks[0], (DEPTH, 2 * M_HEADS), f32),
        forget_bias[None] + 0.1 * nrm(ks[1], (DEPTH, 2 * M_HEADS), f32),
    ], axis=-1)
    conv_center = jnp.array([0.0, 1.0, 0.0], f32).reshape(1, 3, 1)
    return {
        "x_prompt": nrm(ks[2], (BATCH, SEQ, D_MODEL), f32),
        "x_sample": nrm(ks[3], (DEC_BATCH, DEC_SEQ, D_MODEL), f32),
        "w_in": nrm(ks[4], (DEPTH, D_MODEL, IN_COLS), f32) * D_MODEL ** -0.5,
        "b_gates": b_gates,
        "mh_norm_w": 1.0 + 0.05 * nrm(ks[5], (DEPTH, M_WIDTH), f32),
        "q_norm_w": 1.0 + 0.05 * nrm(ks[6], (DEPTH, HEAD_DIM), f32),
        "k_norm_w": 1.0 + 0.05 * nrm(ks[7], (DEPTH, HEAD_DIM), f32),
        "w_out": nrm(ks[8], (DEPTH, MIX_WIDTH, D_MODEL), f32) * MIX_WIDTH ** -0.5,
        "norm1_w": 1.0 + 0.05 * nrm(ks[9], (DEPTH, D_MODEL), f32),
        "norm2_w": 1.0 + 0.05 * nrm(ks[10], (DEPTH, D_MODEL), f32),
        "w_up": nrm(ks[11], (DEPTH, D_MODEL, 2 * D_FF), f32) * D_MODEL ** -0.5,
        "conv_w": conv_center + 0.3 * nrm(ks[12], (DEPTH, CONV_W, 2 * D_FF), f32),
        "conv_b": 0.01 * nrm(ks[13], (DEPTH, 2 * D_FF), f32),
        "w_down": nrm(ks[14], (DEPTH, D_FF, D_MODEL), f32) * D_FF ** -0.5,
        "final_norm_w": 1.0 + 0.05 * nrm(ks[15], (D_MODEL,), f32),
    }


def reference(x_prompt, x_sample, w_in, b_gates, mh_norm_w, q_norm_w, k_norm_w, w_out, norm1_w, norm2_w,
              w_up, conv_w, conv_b, w_down, final_norm_w):
    y_prompt = run_trunk(x_prompt, w_in, b_gates, mh_norm_w, q_norm_w, k_norm_w, w_out, norm1_w, norm2_w,
                         w_up, conv_w, conv_b, w_down, final_norm_w)
    y_sample = run_trunk(x_sample, w_in, b_gates, mh_norm_w, q_norm_w, k_norm_w, w_out, norm1_w, norm2_w,
                         w_up, conv_w, conv_b, w_down, final_norm_w)
    return (y_prompt, y_sample)
```

```cpp
#include <hip/hip_runtime.h>
#include <hip/hip_bf16.h>
#include <cstdio>
#include <cstdint>
#include <cmath>
namespace pg8 {
#define PG8_LAS __attribute__((address_space(3)))
typedef unsigned short bf16_t;
typedef short bf16x8 __attribute__((ext_vector_type(8)));
typedef float f32x4 __attribute__((ext_vector_type(4)));
typedef unsigned u32x4 __attribute__((ext_vector_type(4)));
constexpr int BM = 256, BK = 64, HALF = 128, HTB = HALF * BK * 2  , STAGE_BYTES = 8 * HTB, NXCD = 8, WGM = 8;

__host__ __device__ __forceinline__ int lds_byte(int r, int c) { const int st = (r >> 4) * 2 + (c >> 5), rr = r & 15, cc = c & 31, ob = rr * 64 + cc * 2; return st * 1024 + (ob ^ (((ob >> 9) & 1) << 5)); }
__host__ __device__ __forceinline__ void stage_rc(int b, int& R, int& C) { const int st = b / 1024, sb = b % 1024, swz = sb ^ (((sb >> 9) & 1) << 5); R = (st >> 1) * 16 + swz / 64; C = (st & 1) * 32 + (swz % 64) / 2; }
__host__ __device__ __forceinline__ int perm32(int rho) { const int n = rho >> 4, i = rho & 15; return 8 * (i >> 2) + 4 * n + (i & 3); }

struct Unit { int pm, pn; };
struct Gemm { const bf16_t* A; const bf16_t* Bt; int M, N, K; };

struct StaticOrder {
    int nM, nN, nwg, G, c;
    __host__ __device__ void init(int M, int N, int G_, int c_) { nM = M / BM; nN = N / BM; nwg = nM * nN; G = G_; c = c_; }
    __host__ __device__ bool next(int i, Unit& u) const {
        const long L = (long)i * G + c; if (L >= nwg) return false;
        int wgid = (int)L; { const int q = nwg / NXCD, r = nwg % NXCD, xcd = wgid % NXCD, off = wgid / NXCD; wgid = (xcd < r ? xcd * (q + 1) : r * (q + 1) + (xcd - r) * q) + off; }
        const int nig = WGM * nN, gid = wgid / nig, fm = gid * WGM, gsz = (nM - fm) < WGM ? (nM - fm) : WGM;
        u.pm = fm + ((wgid % nig) % gsz); u.pn = (wgid % nig) / gsz; return true;
    }
    __device__ __forceinline__ void a_ready(const Unit&) const {}
    __device__ __forceinline__ void done(const Unit&) const {}
};

__device__ __forceinline__ unsigned cvt_pk_bf16(float lo, float hi) { unsigned r; asm volatile("v_cvt_pk_bf16_f32 %0, %1, %2" : "=v"(r) : "v"(lo), "v"(hi)); return r; }
typedef float f32x2 __attribute__((ext_vector_type(2)));
constexpr int T0_ROWS = 16384;
struct EpiIn {
    static constexpr bool PERM = true, AFTER_DRAIN = false;
    bf16_t *MIX, *MK, *MV, *MO, *KV; float* G; const float* bg;
    __device__ __forceinline__ void operator()(const f32x4 (&acc)[2][2][4][2], const Unit& u, int wr, int wc, int fr, int fq) const {
        const int row0 = u.pm * BM + wr * 64 + fr; const int pn = u.pn;
        if (pn == 11) {
            if (wc == 0) {
                const f32x4 b0 = *(const f32x4*)(bg + 8 * fq), b1 = *(const f32x4*)(bg + 8 * fq + 4);
#pragma unroll
                for (int ai = 0; ai < 2; ++ai)
#pragma unroll
                    for (int m = 0; m < 4; ++m) { float* gp = G + (size_t)(row0 + ai * HALF + m * 16) * 32 + 8 * fq;
                        *(f32x4*)gp = acc[ai][0][m][0] + b0; *(f32x4*)(gp + 4) = acc[ai][0][m][1] + b1; }
            }
            return;
        }
        bf16_t* base; int ldc; float sc = 1.f;
        if (pn < 2) { base = MIX + pn * 256; ldc = 1024; }
        else if (pn < 4) { base = MK + (pn - 2) * 256; ldc = 512; sc = 0.125f; }
        else if (pn < 6) { base = MV + (pn - 4) * 256; ldc = 512; }
        else if (pn < 8) { base = MO + (pn - 6) * 256; ldc = 512; }
        else if (pn < 10) { base = MIX + 512 + (pn - 8) * 256; ldc = 1024; }
        else { base = KV; ldc = 256; }
        const int col0 = wc * 32 + 8 * fq;
#pragma unroll
        for (int ai = 0; ai < 2; ++ai)
#pragma unroll
            for (int m = 0; m < 4; ++m) { bf16_t* rowp = base + (size_t)(row0 + ai * HALF + m * 16) * ldc + col0;
#pragma unroll
                for (int bj = 0; bj < 2; ++bj) { const f32x4 v0 = acc[ai][bj][m][0] * sc, v1 = acc[ai][bj][m][1] * sc;
                    u32x4 w; w.x = cvt_pk_bf16(v0[0], v0[1]); w.y = cvt_pk_bf16(v0[2], v0[3]); w.z = cvt_pk_bf16(v1[0], v1[1]); w.w = cvt_pk_bf16(v1[2], v1[3]);
                    *(u32x4*)(rowp + bj * HALF) = w; } }
    }
};
template <bool WRITE_B> struct EpiRes {
    static constexpr bool PERM = false, AFTER_DRAIN = false;
    const float* base0; const float* base1; float* out; bf16_t* xb; float* part; int row_off;
    __device__ __forceinline__ void operator()(const f32x4 (&acc)[2][2][4][2], const Unit& u, int wr, int wc, int fr, int fq) const {
        typedef unsigned u32x2v __attribute__((ext_vector_type(2)));
#pragma unroll
        for (int ai = 0; ai < 2; ++ai)
#pragma unroll
            for (int m = 0; m < 4; ++m) {
                const int r = row_off + u.pm * BM + ai * HALF + wr * 64 + m * 16 + fr;
                const float* brow = (r < T0_ROWS) ? base0 + (size_t)r * 1024 : base1 + (size_t)(r - T0_ROWS) * 1024;
                float ss = 0.f;
#pragma unroll
                for (int bj = 0; bj < 2; ++bj)
#pragma unroll
                    for (int n = 0; n < 2; ++n) { const int col = u.pn * BM + bj * HALF + wc * 32 + n * 16 + 4 * fq;
                        const f32x4 o = *(const f32x4*)(brow + col) + acc[ai][bj][m][n];
                        *(f32x4*)(out + (size_t)r * 1024 + col) = o; ss += (o[0] * o[0] + o[1] * o[1]) + (o[2] * o[2] + o[3] * o[3]);
                        if (WRITE_B) { u32x2v w; w.x = cvt_pk_bf16(o[0], o[1]); w.y = cvt_pk_bf16(o[2], o[3]); *(u32x2v*)(xb + (size_t)r * 1024 + col) = w; } }
                ss += __shfl_xor(ss, 16); ss += __shfl_xor(ss, 32);
                if (fq == 0) part[(size_t)r * 16 + u.pn * 4 + wc] = ss;
            }
    }
};
struct EpiUp {
    static constexpr bool PERM = true, AFTER_DRAIN = false;
    bf16_t* U; const float* part; int row_off; int ldu;
    __device__ __forceinline__ void operator()(const f32x4 (&acc)[2][2][4][2], const Unit& u, int wr, int wc, int fr, int fq) const {
        const int col0 = u.pn * BM + wc * 32 + 8 * fq;
#pragma unroll
        for (int ai = 0; ai < 2; ++ai)
#pragma unroll
            for (int m = 0; m < 4; ++m) { const int rl = u.pm * BM + ai * HALF + wr * 64 + m * 16 + fr;
                const f32x4* pp = (const f32x4*)(part + (size_t)(row_off + rl) * 16); const f32x4 a = pp[0], b = pp[1], c = pp[2], d = pp[3];
                const float ss = ((a[0] + a[1]) + (a[2] + a[3])) + ((b[0] + b[1]) + (b[2] + b[3])) + ((c[0] + c[1]) + (c[2] + c[3])) + ((d[0] + d[1]) + (d[2] + d[3]));
                const float rinv = 1.0f / sqrtf(ss * (1.0f / 1024.0f) + 1e-6f);
                bf16_t* rowp = U + (size_t)rl * ldu + col0;
#pragma unroll
                for (int bj = 0; bj < 2; ++bj) { const f32x4 v0 = acc[ai][bj][m][0] * rinv, v1 = acc[ai][bj][m][1] * rinv;
                    u32x4 w; w.x = cvt_pk_bf16(v0[0], v0[1]); w.y = cvt_pk_bf16(v0[2], v0[3]); w.z = cvt_pk_bf16(v1[0], v1[1]); w.w = cvt_pk_bf16(v1[2], v1[3]);
                    *(u32x4*)(rowp + bj * HALF) = w; } }
    }
};

template <class Epi, class Sched, bool ALIGN_EPI = false, bool SP2 = false>
__device__ __forceinline__ void gemm_phase(PG8_LAS unsigned char* lds, const Gemm g, const Sched& S, const Epi& E) {
    const int tid = threadIdx.x, wid = __builtin_amdgcn_readfirstlane(tid >> 6), lane = tid & 63, wr = wid >> 2, wc = wid & 3, fr = lane & 15, fq = lane >> 4;
    const int K = g.K, nt = K / BK;
    unsigned voffA[2], voffB[2];
#pragma unroll
    for (int i = 0; i < 2; ++i) { int R, C; stage_rc(tid * 16 + i * 8192, R, C); const int Rb = Epi::PERM ? ((R & ~31) + perm32(R & 31)) : R;
        voffA[i] = (unsigned)(R * K + C) * 2u; voffB[i] = (unsigned)(Rb * K + C) * 2u; }
    const size_t kstep = (size_t)(BK * 2);
    const size_t hstep = (size_t)HALF * K * 2;
    const size_t tstep = 2 * hstep;
    const unsigned ldsw = (unsigned)wid * 1024u;
    const int aoff = lds_byte(wr * 64 + fr, fq * 8), boff = lds_byte(wc * 32 + fr, fq * 8);
#define PG8_SA(b, h) (((b) * 2 + (h)) * HTB)
#define PG8_SB(b, h) ((4 + (b) * 2 + (h)) * HTB)
#define PG8_STAGE(bufoff, gbase, voff) do { _Pragma("unroll") for (int _i = 0; _i < 2; ++_i) \
        __builtin_amdgcn_global_load_lds((const unsigned*)((const char*)(gbase) + (voff)[_i]), (PG8_LAS unsigned*)(lds + (bufoff) + ldsw + _i * 8192), 16, 0, 0); } while (0)
#define PG8_LDA(dst, b, h) do { _Pragma("unroll") for (int m = 0; m < 4; ++m) _Pragma("unroll") for (int k = 0; k < 2; ++k) dst[m][k] = *(const PG8_LAS bf16x8*)(lds + PG8_SA(b, h) + aoff + m * 2048 + k * 1024); } while (0)
#define PG8_LDB(dst, b, h) do { _Pragma("unroll") for (int n = 0; n < 2; ++n) _Pragma("unroll") for (int k = 0; k < 2; ++k) dst[n][k] = *(const PG8_LAS bf16x8*)(lds + PG8_SB(b, h) + boff + n * 2048 + k * 1024); } while (0)
#define PG8_MMA(ai, bj, At, Bt) do { __builtin_amdgcn_s_setprio(1); _Pragma("unroll") for (int m = 0; m < 4; ++m) _Pragma("unroll") for (int n = 0; n < 2; ++n) _Pragma("unroll") for (int k = 0; k < 2; ++k) \
        acc[ai][bj][m][n] = __builtin_amdgcn_mfma_f32_16x16x32_bf16(Bt[n][k], At[m][k], acc[ai][bj][m][n], 0, 0, 0); __builtin_amdgcn_s_setprio(0); } while (0)
#define PG8_WAIT_V(n) asm volatile("s_waitcnt vmcnt(" #n ")" ::: "memory")
#define PG8_WAIT_L(n) asm volatile("s_waitcnt lgkmcnt(" #n ")" ::: "memory")
#define PG8_BAR __builtin_amdgcn_s_barrier()
#define PG8_SCHED __builtin_amdgcn_sched_barrier(0)
    Unit cur, nxt; int ui = 0;
    if (!S.next(0, cur)) return;
    f32x4 acc[2][2][4][2];
#pragma unroll
    for (int a = 0; a < 2; ++a)
#pragma unroll
        for (int b = 0; b < 2; ++b)
#pragma unroll
            for (int m = 0; m < 4; ++m)
#pragma unroll
                for (int n = 0; n < 2; ++n) acc[a][b][m][n] = (f32x4){0.f, 0.f, 0.f, 0.f};
    bf16x8 At[4][2], B0[2][2], B1[2][2];
    const char* cA = (const char*)g.A + (size_t)cur.pm * tstep; const char* cB = (const char*)g.Bt + (size_t)cur.pn * tstep;
    S.a_ready(cur);
    if constexpr (SP2) {
        PG8_STAGE(PG8_SB(0, 0), cB, voffB); PG8_STAGE(PG8_SB(0, 1), cB + hstep, voffB); PG8_STAGE(PG8_SA(0, 0), cA, voffA); PG8_STAGE(PG8_SA(0, 1), cA + hstep, voffA);
        if (wr == 1) PG8_BAR;
        PG8_WAIT_V(2); PG8_BAR;
        PG8_STAGE(PG8_SB(1, 0), cB + kstep, voffB); PG8_STAGE(PG8_SA(1, 0), cA + kstep, voffA); PG8_STAGE(PG8_SB(1, 1), cB + hstep + kstep, voffB);
        PG8_WAIT_V(6); PG8_BAR;
    } else {
        PG8_STAGE(PG8_SB(0, 0), cB, voffB); PG8_STAGE(PG8_SA(0, 0), cA, voffA); PG8_STAGE(PG8_SB(0, 1), cB + hstep, voffB); PG8_STAGE(PG8_SA(0, 1), cA + hstep, voffA);
        if (wr == 1) PG8_BAR;
        PG8_WAIT_V(4); PG8_BAR;
        PG8_STAGE(PG8_SB(1, 0), cB + kstep, voffB); PG8_STAGE(PG8_SA(1, 0), cA + kstep, voffA); PG8_STAGE(PG8_SB(1, 1), cB + hstep + kstep, voffB);
        PG8_WAIT_V(6); PG8_BAR;
    }
    for (;;) {
        const bool has_next = S.next(ui + 1, nxt);
        const char* nA = has_next ? (const char*)g.A + (size_t)nxt.pm * tstep : cA; const char* nB = has_next ? (const char*)g.Bt + (size_t)nxt.pn * tstep : cB;
        for (int t = 0; t < nt; t += 2) {
            const bool last = (t == nt - 2);
            const char* a1 = cA + (size_t)(t + 1) * kstep;
            const char* a2 = last ? nA : cA + (size_t)(t + 2) * kstep; const char* b2 = last ? nB : cB + (size_t)(t + 2) * kstep;
            const char* a3 = a2 + kstep; const char* b3 = b2 + kstep;
            if (last && has_next) S.a_ready(nxt);
            if constexpr (SP2) {
            PG8_LDB(B0, 0, 0); PG8_LDB(B1, 0, 1); PG8_SCHED; PG8_LDA(At, 0, 0); PG8_STAGE(PG8_SA(1, 1), a1 + hstep, voffA);
            PG8_WAIT_V(8); PG8_WAIT_L(0); PG8_BAR; PG8_MMA(0, 0, At, B0); PG8_MMA(0, 1, At, B1); PG8_BAR; PG8_SCHED;
            PG8_LDA(At, 0, 1); PG8_STAGE(PG8_SB(0, 0), b2, voffB); PG8_STAGE(PG8_SB(0, 1), b2 + hstep, voffB); PG8_STAGE(PG8_SA(0, 0), a2, voffA);
            PG8_WAIT_V(8); PG8_WAIT_L(0); PG8_BAR; PG8_MMA(1, 0, At, B0); PG8_MMA(1, 1, At, B1); PG8_BAR; PG8_SCHED;
            PG8_LDB(B0, 1, 0); PG8_LDB(B1, 1, 1); PG8_SCHED; PG8_LDA(At, 1, 0); PG8_STAGE(PG8_SA(0, 1), a2 + hstep, voffA);
            PG8_WAIT_V(8); PG8_WAIT_L(0); PG8_BAR; PG8_MMA(0, 0, At, B0); PG8_MMA(0, 1, At, B1); PG8_BAR; PG8_SCHED;
            PG8_LDA(At, 1, 1); PG8_STAGE(PG8_SB(1, 0), b3, voffB); PG8_STAGE(PG8_SB(1, 1), b3 + hstep, voffB); PG8_STAGE(PG8_SA(1, 0), a3, voffA);
            PG8_WAIT_V(8); PG8_WAIT_L(0); PG8_BAR; PG8_MMA(1, 0, At, B0); PG8_MMA(1, 1, At, B1); PG8_BAR; PG8_SCHED;
            } else {
            PG8_LDB(B0, 0, 0); PG8_SCHED; PG8_LDA(At, 0, 0); PG8_STAGE(PG8_SA(1, 1), a1 + hstep, voffA);
            PG8_WAIT_L(8); PG8_BAR; PG8_WAIT_L(0); PG8_MMA(0, 0, At, B0); PG8_BAR; PG8_SCHED;
            PG8_LDB(B1, 0, 1); PG8_STAGE(PG8_SB(0, 0), b2, voffB);
            PG8_BAR; PG8_WAIT_L(0); PG8_MMA(0, 1, At, B1); PG8_BAR;
            PG8_LDA(At, 0, 1); PG8_STAGE(PG8_SA(0, 0), a2, voffA);
            PG8_BAR; PG8_WAIT_L(0); PG8_MMA(1, 0, At, B0); PG8_BAR; PG8_SCHED;
            PG8_STAGE(PG8_SB(0, 1), b2 + hstep, voffB);
            PG8_WAIT_V(6); PG8_BAR; PG8_MMA(1, 1, At, B1); PG8_BAR;
            PG8_LDB(B0, 1, 0); PG8_SCHED; PG8_LDA(At, 1, 0); PG8_STAGE(PG8_SA(0, 1), a2 + hstep, voffA);
            PG8_WAIT_L(8); PG8_BAR; PG8_WAIT_L(0); PG8_MMA(0, 0, At, B0); PG8_BAR; PG8_SCHED;
            PG8_LDB(B1, 1, 1); PG8_STAGE(PG8_SB(1, 0), b3, voffB);
            PG8_BAR; PG8_WAIT_L(0); PG8_MMA(0, 1, At, B1); PG8_BAR;
            PG8_LDA(At, 1, 1); PG8_STAGE(PG8_SA(1, 0), a3, voffA);
            PG8_BAR; PG8_WAIT_L(0); PG8_MMA(1, 0, At, B0); PG8_BAR; PG8_SCHED;
            PG8_STAGE(PG8_SB(1, 1), b3 + hstep, voffB);
            PG8_WAIT_V(6); PG8_BAR; PG8_MMA(1, 1, At, B1); PG8_BAR;
            }
        }
        if constexpr (ALIGN_EPI) { if (wr == 0) PG8_BAR; }
        if constexpr (!Epi::AFTER_DRAIN) { E(acc, cur, wr, wc, fr, fq); S.done(cur); }
        if (!has_next) break;
#pragma unroll
        for (int a = 0; a < 2; ++a)
#pragma unroll
            for (int b = 0; b < 2; ++b)
#pragma unroll
                for (int m = 0; m < 4; ++m)
#pragma unroll
                    for (int n = 0; n < 2; ++n) acc[a][b][m][n] = (f32x4){0.f, 0.f, 0.f, 0.f};
        cur = nxt; cA = nA; cB = nB; ++ui;
        if constexpr (ALIGN_EPI) { if (wr == 1) PG8_BAR; }
    }
    PG8_WAIT_V(0);
    if constexpr (!ALIGN_EPI) { if (wr == 0) PG8_BAR; }
    PG8_BAR;
    if constexpr (Epi::AFTER_DRAIN) { E.fused(acc, cur, wr, wc, fr, fq, lds, wid, lane); S.done(cur); }
#undef PG8_SA
#undef PG8_SB
#undef PG8_STAGE
#undef PG8_LDA
#undef PG8_LDB
#undef PG8_MMA
#undef PG8_WAIT_V
#undef PG8_WAIT_L
#undef PG8_BAR
#undef PG8_SCHED
}
}

namespace attn_body {
using bf16=__hip_bfloat16;
using bf16x8=__attribute__((ext_vector_type(8)))short;
using s16x4=__attribute__((ext_vector_type(4)))short;
using f32x16=__attribute__((ext_vector_type(16)))float;
using u32x4=__attribute__((ext_vector_type(4)))unsigned;
constexpr int D=64,QP=1024,KVP=256;
constexpr int NW=8,QBLK=32,QB=QBLK*NW,KVBLK=64;
constexpr int ATTN_UNIT_ROWS=QB;
__device__ __forceinline__ int crow(int r,int hi){return (r&3)+8*(r>>2)+4*hi;}
#define SBAR() __builtin_amdgcn_sched_barrier(0)
__device__ __forceinline__ void cmask(f32x16&p0,f32x16&p1,int jb,int qrel,int hi){
  const float NEG=-INFINITY; int kb=64*jb+4*hi;
  #pragma unroll
  for(int r=0;r<16;++r){int kv=kb+(r&3)+8*(r>>2); if(kv>qrel)p0[r]=NEG; if(kv+32>qrel)p1[r]=NEG;}
}

constexpr int NSLOT=3, SLOTB=8192;
constexpr int LDS_K=0, LDS_V=NSLOT*SLOTB, LDS_WS=2*NSLOT*SLOTB, LDS_OST=LDS_WS+NW*64*4, LDS_BYTES=LDS_OST+NW*4096;
constexpr float C2=0.125f*1.4426950408889634f;
__device__ __forceinline__ void glds16(const void*gsrc,unsigned lds_dst){unsigned keep;
  asm volatile("s_mov_b32 %0, m0\n\ts_mov_b32 m0, %2\n\ts_nop 0\n\tglobal_load_lds_dwordx4 %1, off\n\ts_mov_b32 m0, %0":"=&s"(keep):"v"(gsrc),"s"(lds_dst):"memory");}
__device__ __forceinline__ float max3f(float a,float b,float c){float r;asm("v_max3_f32 %0, %1, %2, %3":"=v"(r):"v"(a),"v"(b),"v"(c));return r;}
__device__ __forceinline__ float max2f(float a,float b){float r;asm("v_max_f32_e32 %0, %1, %2":"=v"(r):"v"(a),"v"(b));return r;}
__device__ __forceinline__ float fadd_s(float a,float b){float r;asm("v_add_f32_e32 %0, %1, %2":"=v"(r):"v"(a),"v"(b));return r;}
__device__ __forceinline__ float fsub_s(float a,float b){float r;asm("v_sub_f32_e32 %0, %1, %2":"=v"(r):"v"(a),"v"(b));return r;}
typedef float f32x2_t __attribute__((ext_vector_type(2))); typedef __bf16 bf16x2_t __attribute__((ext_vector_type(2)));
__device__ __forceinline__ unsigned cvtpk_s(float lo,float hi){f32x2_t v={lo,hi};bf16x2_t b=__builtin_convertvector(v,bf16x2_t);return __builtin_bit_cast(unsigned,b);}
#define WAIT_BAR(N) asm volatile("s_waitcnt vmcnt(" #N ") lgkmcnt(0)\n\ts_barrier":::"memory")

__device__ __forceinline__ void qkt(f32x16&p0,f32x16&p1,const char*Kslot,const bf16x8*qr,const f32x16&negm,int r32,int hi){
  const char*kb=Kslot+hi*1024+r32*16;
  #pragma unroll
  for(int d0=0;d0<4;++d0){
    const bf16x8 b0=*reinterpret_cast<const bf16x8*>(kb+d0*2048);
    const bf16x8 b1=*reinterpret_cast<const bf16x8*>(kb+d0*2048+512);
    if(d0==0){p0=__builtin_amdgcn_mfma_f32_32x32x16_bf16(b0,qr[0],negm,0,0,0);p1=__builtin_amdgcn_mfma_f32_32x32x16_bf16(b1,qr[0],negm,0,0,0);}
    else{p0=__builtin_amdgcn_mfma_f32_32x32x16_bf16(b0,qr[d0],p0,0,0,0);p1=__builtin_amdgcn_mfma_f32_32x32x16_bf16(b1,qr[d0],p1,0,0,0);}}
}
typedef __attribute__((address_space(3))) const char* lds_cptr;
typedef short v4i16_t __attribute__((ext_vector_type(4)));
__device__ __forceinline__ void kload8(bf16x8*kf,lds_cptr kp){
  kf[0]=*(const __attribute__((address_space(3))) bf16x8*)(kp);      kf[1]=*(const __attribute__((address_space(3))) bf16x8*)(kp+512);
  kf[2]=*(const __attribute__((address_space(3))) bf16x8*)(kp+2048); kf[3]=*(const __attribute__((address_space(3))) bf16x8*)(kp+2560);
  kf[4]=*(const __attribute__((address_space(3))) bf16x8*)(kp+4096); kf[5]=*(const __attribute__((address_space(3))) bf16x8*)(kp+4608);
  kf[6]=*(const __attribute__((address_space(3))) bf16x8*)(kp+6144); kf[7]=*(const __attribute__((address_space(3))) bf16x8*)(kp+6656);
}
__device__ __forceinline__ void kload2(bf16x8*kf,lds_cptr kp,int j){ kf[2*j]=*(const __attribute__((address_space(3))) bf16x8*)(kp+j*2048); kf[2*j+1]=*(const __attribute__((address_space(3))) bf16x8*)(kp+j*2048+512); }
__device__ __forceinline__ s16x4 vtr(lds_cptr p){ return __builtin_bit_cast(s16x4,__builtin_amdgcn_ds_read_tr16_b64_v4i16((__attribute__((address_space(3))) v4i16_t*)p)); }
__device__ __forceinline__ float rowmax(const f32x16&p0,const f32x16&p1){
  float a=max3f(p0[0],p0[1],p1[0]),b=max3f(p0[2],p0[3],p1[1]);a=max3f(a,p1[2],p1[3]);
  #pragma unroll
  for(int r=4;r<16;r+=4){a=max3f(a,p0[r],p0[r+1]);b=max3f(b,p0[r+2],p0[r+3]);a=max3f(a,p1[r],p1[r+1]);b=max3f(b,p1[r+2],p1[r+3]);}
  const float m=max2f(a,b);
  auto rr=__builtin_amdgcn_permlane32_swap(__float_as_uint(m),__float_as_uint(m),false,false);
  return max2f(__uint_as_float(rr[0]),__uint_as_float(rr[1]));
}
__device__ __forceinline__ void pv(f32x16*o,int vb,bf16x8 pa0,bf16x8 pa1,bf16x8 pa2,bf16x8 pa3){
  #pragma unroll
  for(int d0=0;d0<2;++d0){s16x4 lo[4],hi[4];
    #pragma unroll
    for(int ks=0;ks<4;++ks){
      asm volatile("ds_read_b64_tr_b16 %0,%1 offset:%c2":"=&v"(lo[ks]):"v"(vb),"i"(d0*4096+ks*1024):"memory");
      asm volatile("ds_read_b64_tr_b16 %0,%1 offset:%c2":"=&v"(hi[ks]):"v"(vb),"i"(d0*4096+ks*1024+512):"memory");}
    asm volatile("s_waitcnt lgkmcnt(0)":::"memory");SBAR();
    #define PK(k) (bf16x8){lo[k][0],lo[k][1],lo[k][2],lo[k][3],hi[k][0],hi[k][1],hi[k][2],hi[k][3]}
    o[d0]=__builtin_amdgcn_mfma_f32_32x32x16_bf16(pa0,PK(0),o[d0],0,0,0);
    o[d0]=__builtin_amdgcn_mfma_f32_32x32x16_bf16(pa1,PK(1),o[d0],0,0,0);
    o[d0]=__builtin_amdgcn_mfma_f32_32x32x16_bf16(pa2,PK(2),o[d0],0,0,0);
    o[d0]=__builtin_amdgcn_mfma_f32_32x32x16_bf16(pa3,PK(3),o[d0],0,0,0);
    #undef PK
  }
}

#ifndef ATTN_STORE16
#define ATTN_STORE16(p,v) (*(u32x4*)(p)=(v))
#endif
template<int THRL> __device__ __forceinline__ void attn_unit(long rowbase,int NT,int qcol,int kcol,int vcol,int qb,const bf16*Q,const bf16*__restrict__ K,const bf16*__restrict__ V,bf16*O,char*shm){
  const int tid=threadIdx.x,lane=tid&63,r32=lane&31,hi=lane>>5; const int wid=__builtin_amdgcn_readfirstlane(tid>>6);
  const int q0=qb*QB;
  const bf16*Qw=Q+(rowbase+q0+wid*QBLK)*QP+qcol;
  const bf16*Kh=K+rowbase*KVP+kcol,*Vh=V+rowbase*KVP+vcol;
  const unsigned lds0=(unsigned)(uintptr_t)shm;
  float*wsf=(float*)(shm+LDS_WS)+wid*64;
  const bf16*ksrc=Kh+(long)lane*KVP+wid*8;
  const bf16*vsrc=Vh+(long)(16*(wid&3)+(lane>>2))*KVP+(wid>>2)*32+(lane&3)*8;
  const unsigned kdst=lds0+LDS_K+wid*1024, vdst=lds0+LDS_V+wid*1024;
  #define DMA_K(t,slot) glds16(ksrc+(long)(t)*KVBLK*KVP,(unsigned)__builtin_amdgcn_readfirstlane(kdst+(slot)))
  #define DMA_V(t,slot) glds16(vsrc+(long)(t)*KVBLK*KVP,(unsigned)__builtin_amdgcn_readfirstlane(vdst+(slot)))
  const int vb0=(int)(lds0+LDS_V)+((lane>>4)&1)*32+(lane&3)*8+(4*hi+((lane&15)>>2))*64;
  const char*Kbase=shm+LDS_K; bf16x8 kf[8];
  const lds_cptr shm3=(lds_cptr)shm; const lds_cptr kp0=shm3+LDS_K+hi*1024+r32*16; const lds_cptr vp0=shm3+LDS_V+((lane>>4)&1)*32+(lane&3)*8+(4*hi+((lane&15)>>2))*64;
  DMA_K(0,0);DMA_V(0,0);DMA_K(1,SLOTB);
  bf16x8 qr[4];
  #pragma unroll
  for(int d0=0;d0<4;++d0)qr[d0]=*reinterpret_cast<const bf16x8*>(&Qw[(long)r32*QP+d0*16+hi*8]);
  float mhat=0.f,l_reg=0.f;f32x16 o[2];o[0]=f32x16{};o[1]=f32x16{};f32x16 negm=f32x16{};asm volatile("":"+v"(negm));
  #define CMASK(P0,P1,t) do{}while(0)
  bool resc=false;
  #define START(P0,P1) do{ const float rm=rowmax(P0,P1); resc=false; \
    { const float dl=rm; mhat=fadd_s(mhat,dl); \
      _Pragma("unroll") for(int r=0;r<16;++r){P0[r]=fsub_s(P0[r],dl);P1[r]=fsub_s(P1[r],dl);} \
      _Pragma("unroll") for(int r=0;r<16;++r)negm[r]=-mhat; asm volatile("":"+v"(negm)); } \
    _Pragma("unroll") for(int r=0;r<16;++r)P0[r]=__builtin_amdgcn_exp2f(P0[r]); }while(0)
  #define RESC() do{ if(resc){ asm volatile("s_waitcnt lgkmcnt(0)":::"memory"); \
      _Pragma("unroll") for(int d_=0;d_<2;++d_) _Pragma("unroll") for(int r=0;r<16;++r)o[d_][r]*=wsf[crow(r,hi)]; } }while(0)
  f32x16 pA0,pA1,pB0,pB1;
  int sl_prev=0,sl_cur=0,sl_next=SLOTB;
  #define ROT() do{sl_prev=sl_cur;sl_cur=sl_next;sl_next=(sl_next==(NSLOT-1)*SLOTB)?0:sl_next+SLOTB;}while(0)
  DMA_K(2,2*SLOTB);
  WAIT_BAR(3);
  qkt(pA0,pA1,Kbase,qr,negm,r32,hi);asm volatile("s_nop 15\n\ts_nop 7":"+v"(pA0),"+v"(pA1));CMASK(pA0,pA1,0);
  START(pA0,pA1);
  _Pragma("unroll") for(int r=0;r<16;++r)pA1[r]=__builtin_amdgcn_exp2f(pA1[r]);
  WAIT_BAR(0);
  DMA_K(3,0);DMA_V(1,SLOTB);
  ROT();
  kload8(kf,kp0+sl_cur);
  WAIT_BAR(2);
  s16x4 vlo[8],vhi[8]; u32x4 pw0,pw1,pw2,pw3;
  #define PKW(P,B) cvtpk_s(P[B],P[B+1])
  #define PAF(k) __builtin_bit_cast(bf16x8,pw##k)
  #define VFR(i) (bf16x8){vlo[i][0],vlo[i][1],vlo[i][2],vlo[i][3],vhi[i][0],vhi[i][1],vhi[i][2],vhi[i][3]}
  #define PIN(x) asm volatile("":"+v"(x))
  #define MX3(a,b,c) __builtin_fmaxf(__builtin_fmaxf((a),(b)),(c))
  #define GAPA(MF,A0,A1,A2,A3,W0,W1,PW) do{ MF; sacc+=A0; sacc+=A1; sacc+=A2; sacc+=A3; PIN(sacc); W0; W1; PIN(PW); SBAR(); }while(0)
  #define EX(v) __builtin_amdgcn_exp2f(v)
  #define GAPB(MF,X,B) do{ MF; X[B]=EX(X[B]); X[B+1]=EX(X[B+1]); X[B+2]=EX(X[B+2]); X[B+3]=EX(X[B+3]); PIN(X); SBAR(); }while(0)
  #define VRD(i) do{ vlo[i]=vtr(vp_+(((i)>>2)*4096+((i)&3)*1024)); vhi[i]=vtr(vp_+(((i)>>2)*4096+((i)&3)*1024+512)); }while(0)
  #define KRD(G,j) do{ if(G){ kload2(kf,kp0+sl_next,j); SBAR(); } }while(0)
  #define STEP(C0,C1,P0,P1,t,GK,GV,GL) do{ SBAR(); \
    const lds_cptr vp_=vp0+sl_prev; \
    VRD(0); SBAR(); float sacc=(P0[0]+P0[1]); \
    GAPA(C0=__builtin_amdgcn_mfma_f32_32x32x16_bf16(kf[0],qr[0],negm,0,0,0), P0[2],P0[3],P0[4],P0[5],     pw0[0]=PKW(P0,0), pw0[1]=PKW(P0,2), pw0); \
    VRD(4); SBAR(); GAPA(C1=__builtin_amdgcn_mfma_f32_32x32x16_bf16(kf[1],qr[0],negm,0,0,0), P0[6],P0[7],P0[8],P0[9],     pw0[2]=PKW(P0,4), pw0[3]=PKW(P0,6), pw0); \
    VRD(1); SBAR(); GAPA(C0=__builtin_amdgcn_mfma_f32_32x32x16_bf16(kf[2],qr[1],C0,0,0,0),   P0[10],P0[11],P0[12],P0[13], pw1[0]=PKW(P0,8), pw1[1]=PKW(P0,10), pw1); \
    VRD(5); SBAR(); GAPA(C1=__builtin_amdgcn_mfma_f32_32x32x16_bf16(kf[3],qr[1],C1,0,0,0),   P0[14],P0[15],P1[0],P1[1],   pw1[2]=PKW(P0,12),pw1[3]=PKW(P0,14), pw1); \
    VRD(2); SBAR(); GAPA(C0=__builtin_amdgcn_mfma_f32_32x32x16_bf16(kf[4],qr[2],C0,0,0,0),   P1[2],P1[3],P1[4],P1[5],     pw2[0]=PKW(P1,0), pw2[1]=PKW(P1,2), pw2); \
    VRD(6); SBAR(); GAPA(C1=__builtin_amdgcn_mfma_f32_32x32x16_bf16(kf[5],qr[2],C1,0,0,0),   P1[6],P1[7],P1[8],P1[9],     pw2[2]=PKW(P1,4), pw2[3]=PKW(P1,6), pw2); \
    VRD(3); SBAR(); GAPA(C0=__builtin_amdgcn_mfma_f32_32x32x16_bf16(kf[6],qr[3],C0,0,0,0),   P1[10],P1[11],P1[12],P1[13], pw3[0]=PKW(P1,8), pw3[1]=PKW(P1,10), pw3); \
    VRD(7); SBAR(); GAPA(C1=__builtin_amdgcn_mfma_f32_32x32x16_bf16(kf[7],qr[3],C1,0,0,0),   P1[14],P1[15],0.f,0.f,       pw3[2]=PKW(P1,12),pw3[3]=PKW(P1,14), pw3); \
    l_reg+=sacc; \
    if(GK){DMA_K((t)+3,sl_cur);} if(GV){DMA_V((t)+1,sl_next);} \
    CMASK(C0,C1,t); \
    { float a=MX3(C0[0],C0[1],C1[0]),b=MX3(C0[2],C0[3],C1[1]); a=MX3(a,C1[2],C1[3]); \
      _Pragma("unroll") for(int r=4;r<16;r+=4){a=MX3(a,C0[r],C0[r+1]);b=MX3(b,C0[r+2],C0[r+3]);a=MX3(a,C1[r],C1[r+1]);b=MX3(b,C1[r+2],C1[r+3]);} \
      float rm=__builtin_fmaxf(a,b); { auto rr=__builtin_amdgcn_permlane32_swap(__float_as_uint(rm),__float_as_uint(rm),false,false); rm=__builtin_fmaxf(__uint_as_float(rr[0]),__uint_as_float(rr[1])); } \
      resc=false; \
      if(__builtin_expect(__any(rm>(float)THRL),0)){ const float dl=__builtin_fmaxf(rm,0.f); mhat+=dl; \
        _Pragma("unroll") for(int r=0;r<16;++r){C0[r]-=dl;C1[r]-=dl;} \
        _Pragma("unroll") for(int r=0;r<16;++r)negm[r]=-mhat; asm volatile("":"+v"(negm)); \
        const float f=__builtin_amdgcn_exp2f(-dl); l_reg*=f; if(hi==0)wsf[r32]=f; resc=true; } } \
    SBAR(); \
    GAPB(o[0]=__builtin_amdgcn_mfma_f32_32x32x16_bf16(PAF(0),VFR(0),o[0],0,0,0), C0,0); \
    GAPB(o[1]=__builtin_amdgcn_mfma_f32_32x32x16_bf16(PAF(0),VFR(4),o[1],0,0,0), C0,4); \
    KRD(GL,0); GAPB(o[0]=__builtin_amdgcn_mfma_f32_32x32x16_bf16(PAF(1),VFR(1),o[0],0,0,0), C0,8); \
    KRD(GL,1); GAPB(o[1]=__builtin_amdgcn_mfma_f32_32x32x16_bf16(PAF(1),VFR(5),o[1],0,0,0), C0,12); \
    KRD(GL,2); GAPB(o[0]=__builtin_amdgcn_mfma_f32_32x32x16_bf16(PAF(2),VFR(2),o[0],0,0,0), C1,0); \
    KRD(GL,3); GAPB(o[1]=__builtin_amdgcn_mfma_f32_32x32x16_bf16(PAF(2),VFR(6),o[1],0,0,0), C1,4); \
    GAPB(o[0]=__builtin_amdgcn_mfma_f32_32x32x16_bf16(PAF(3),VFR(3),o[0],0,0,0), C1,8); \
    GAPB(o[1]=__builtin_amdgcn_mfma_f32_32x32x16_bf16(PAF(3),VFR(7),o[1],0,0,0), C1,12); \
    }while(0)
  int t=1;
  #undef CMASK
  #define CMASK(P0,P1,t) do{}while(0)
  for(;t+5<NT;t+=2){
    STEP(pB0,pB1,pA0,pA1,t,true,true,true);     WAIT_BAR(2); RESC(); ROT();
    STEP(pA0,pA1,pB0,pB1,t+1,true,true,true);   WAIT_BAR(2); RESC(); ROT();
  }
  #undef CMASK
  #define CMASK(P0,P1,t) do{}while(0)
  #define ENDW(tt) do{ if((tt)+3<NT){WAIT_BAR(2);} else if((tt)+2<NT){WAIT_BAR(1);} else {WAIT_BAR(0);} }while(0)
  for(;t+1<NT;t+=2){
    STEP(pB0,pB1,pA0,pA1,t,(t+3<NT),(t+1<NT),(t+1<NT));       ENDW(t);   RESC(); ROT();
    STEP(pA0,pA1,pB0,pB1,t+1,(t+4<NT),(t+2<NT),(t+2<NT));     ENDW(t+1); RESC(); ROT();
  }
  STEP(pB0,pB1,pA0,pA1,NT-1,false,false,false); RESC();
  { float sacc=pB0[0]+pB0[1]; _Pragma("unroll") for(int r=2;r<16;++r)sacc+=pB0[r]; _Pragma("unroll") for(int r=0;r<16;++r)sacc+=pB1[r]; l_reg+=sacc;
    pw0=(u32x4){PKW(pB0,0),PKW(pB0,2),PKW(pB0,4),PKW(pB0,6)};pw1=(u32x4){PKW(pB0,8),PKW(pB0,10),PKW(pB0,12),PKW(pB0,14)};pw2=(u32x4){PKW(pB1,0),PKW(pB1,2),PKW(pB1,4),PKW(pB1,6)};pw3=(u32x4){PKW(pB1,8),PKW(pB1,10),PKW(pB1,12),PKW(pB1,14)};
    SBAR(); pv(o,vb0+sl_cur,PAF(0),PAF(1),PAF(2),PAF(3)); }
  #undef PKW
  #undef PAF
  #undef VFR
  #undef PIN
  #undef MX3
  #undef GAPA
  #undef GAPB
  #undef EX
  #undef VRD
  #undef KRD
  #undef STEP
  #undef ENDW
  {auto rr=__builtin_amdgcn_permlane32_swap(__float_as_uint(l_reg),__float_as_uint(l_reg),false,false);l_reg=__uint_as_float(rr[0])+__uint_as_float(rr[1]);}
  if(hi==0)wsf[32+r32]=l_reg;asm volatile("s_waitcnt lgkmcnt(0)":::"memory");
  float rli[16];
  #pragma unroll
  for(int r=0;r<16;++r)rli[r]=__builtin_amdgcn_rcpf(wsf[32+crow(r,hi)]);
  bf16*Ow=O+(rowbase+q0+wid*QBLK)*QP+qcol;
  { bf16*stg=(bf16*)(shm+LDS_OST)+wid*2048;
    #pragma unroll
    for(int r=0;r<16;++r){const int orow=crow(r,hi);
      #pragma unroll
      for(int d0=0;d0<2;++d0)stg[orow*64+d0*32+r32]=__float2bfloat16(o[d0][r]*rli[r]);}
    asm volatile("s_waitcnt lgkmcnt(0)":::"memory");
    #pragma unroll
    for(int i=0;i<4;++i){const int row=i*8+(lane>>3),ch=lane&7; const u32x4 v=*(const u32x4*)(stg+row*64+ch*8); ATTN_STORE16(Ow+(long)row*QP+ch*8,v);} }
  asm volatile("s_waitcnt lgkmcnt(0)\n\ts_barrier":::"memory");
  #undef DMA_K
  #undef DMA_V
  #undef CMASK
  #undef START
  #undef RESC
  #undef ROT
}
constexpr int ATTN_LDS_BYTES=LDS_BYTES;
#undef SBAR
#undef WAIT_BAR
}

namespace attn_body {
struct AttnUnit { long rowbase; int NT, h, qb; };
struct UnitOrder {
  int vcu, G;
  __device__ __forceinline__ UnitOrder(int grid,int v):vcu(v),G(grid){}
  __device__ __forceinline__ bool next(int i,AttnUnit&u)const{
    const int v=vcu+(i/6)*G, j=i%6; if(v>=256)return false;
    if(j<2){ const int pu=2*v+j; u.rowbase=0; u.NT=256; u.h=pu>>6; u.qb=pu&63; }
    else { const int su=4*v+(j-2); u.rowbase=16384+(long)(su>>6)*2048; u.NT=32; u.h=(su>>3)&7; u.qb=su&7; }
    return true; }
};
template<int THRL=8> __device__ __forceinline__ void attn_phase(char*lds,const bf16*MIXQ,const bf16*KV,bf16*MIXO,const UnitOrder&S){
  AttnUnit u;
  for(int i=0;S.next(i,u);++i){ attn_unit<THRL>(u.rowbase,u.NT,512+u.h*64,(u.h>>2)*64,128+(u.h>>2)*64,u.qb,MIXQ,KV,KV,MIXO,lds); }
}
}

constexpr int NWAVES = 8;
constexpr int DM = 1024, T0 = 16384, NSEQ1 = 16, T1 = 2048, M = T0 + NSEQ1 * T1;
constexpr int HD = 64, NH = 8, MW = 512, INC = 2848, INP = 3072, FF = 2816, FF2 = 5632;
constexpr float EPS = 1e-6f;
static_assert(M == 49152 && M % 256 == 0 && pg8::T0_ROWS == T0, "shapes");

constexpr size_t MiB = 1u << 20;
constexpr size_t WS_CTL = 0, CTL_ZERO_BYTES = 1 * MiB;
constexpr size_t WS_WIN = 2 * MiB, WS_WOUT = 8 * MiB, WS_WUP = 10 * MiB, WS_WDN = 21 * MiB;
constexpr size_t WS_ROPE = 27 * MiB;
constexpr size_t WS_PART1 = 28 * MiB, WS_PART2 = 31 * MiB;
constexpr size_t WS_G = 34 * MiB;
constexpr size_t WS_KV = 40 * MiB;
constexpr size_t WS_XN = 64 * MiB;
constexpr size_t WS_MIX = 160 * MiB;
constexpr size_t WS_MK = 256 * MiB, WS_MV = 304 * MiB, WS_MO = 352 * MiB;
constexpr size_t WS_HF = 400 * MiB;
constexpr size_t WS_U = 160 * MiB, WS_ACT = 336 * MiB;
constexpr size_t WS_END = 496 * MiB;
constexpr int CW_BAR = 4096;

constexpr int RING_OFF = 0, RING_BYTES = 131072;
constexpr int LDSCTL_OFF = RING_BYTES, MISC_OFF = LDSCTL_OFF + 320;
constexpr int LDS_BYTES = 147456;

#define GAS __attribute__((address_space(1)))
#define LAS __attribute__((address_space(3)))
typedef unsigned short bf16;
typedef unsigned v4u __attribute__((ext_vector_type(4)));
typedef float f32x4 __attribute__((ext_vector_type(4)));
typedef GAS unsigned gu32;
#define RLX_AGENT __ATOMIC_RELAXED, __HIP_MEMORY_SCOPE_AGENT
#define LDS_WAIT() asm volatile("s_waitcnt lgkmcnt(0)" ::: "memory")
#define VM_WAIT() asm volatile("s_waitcnt vmcnt(0)" ::: "memory")
__device__ __forceinline__ unsigned f2bf(float f) { unsigned u = __builtin_bit_cast(unsigned, f); return (u + 0x7fffu + ((u >> 16) & 1u)) >> 16; }
__device__ __forceinline__ unsigned pk2(float lo, float hi) { return f2bf(lo) | (f2bf(hi) << 16); }
__device__ __forceinline__ float bf2f(unsigned short b) { return __builtin_bit_cast(float, (unsigned)b << 16); }
__device__ __forceinline__ float bflo(unsigned w) { return __builtin_bit_cast(float, w << 16); }
__device__ __forceinline__ float bfhi(unsigned w) { return __builtin_bit_cast(float, w & 0xffff0000u); }
#define XB_TMO      128
#define XB_XCNT(j)  (256  + 64 * (j))
#define XB_XSUB(j)  (1280 + 64 * (j))
#define XB_XGEN(j)  (2304 + 64 * (j))
#define XB_TOP      3328
#define XB_TOPGEN   3392
#define XCD_BAR_WORDS 3456
#define XB_SPIN_CAP (1u << 18)

__device__ __forceinline__ unsigned xb_ld(unsigned* p)              { return __hip_atomic_load(p, __ATOMIC_RELAXED, __HIP_MEMORY_SCOPE_AGENT); }
__device__ __forceinline__ unsigned xb_add(unsigned* p, unsigned v) { return __hip_atomic_fetch_add(p, v, __ATOMIC_RELAXED, __HIP_MEMORY_SCOPE_AGENT); }
__device__ __forceinline__ unsigned xb_xcc_id() { return (unsigned)__builtin_amdgcn_s_getreg((3 << 11) | 20) & 0xFu; }
#define XB_SPIN(cond, bar) do { unsigned _sp = 0; while (cond) { __builtin_amdgcn_s_sleep(1); \
    if ((++_sp & 255u) == 0u) { if (xb_ld(&(bar)[XB_TMO])) break; if (_sp > XB_SPIN_CAP) { atomicAdd(&(bar)[XB_TMO], 1u); break; } } } } while (0)

struct XcdBarrier {
    unsigned* bar; unsigned x;
    volatile LAS unsigned* st;
};

__device__ __forceinline__ XcdBarrier xcd_barrier_post(unsigned* bar, volatile LAS unsigned* st) {
    XcdBarrier b; b.bar = bar; b.x = xb_xcc_id(); b.st = st;
    if (threadIdx.x == 0) (void)xb_add(&bar[XB_XCNT(b.x)], 1u);
    return b;
}
__device__ __forceinline__ void xcd_barrier_complete(unsigned* bar, unsigned x, unsigned& nloc, unsigned& nx) {
    const unsigned G = gridDim.x * gridDim.y * gridDim.z;
    unsigned sum, cnt, mine, sp = 0u;
    for (;;) {
        sum = 0u; cnt = 0u; mine = 0u;
#pragma unroll
        for (unsigned j = 0; j < 16; ++j) { const unsigned c = xb_ld(&bar[XB_XCNT(j)]); sum += c; cnt += (c > 0u) ? 1u : 0u; mine = (j == x) ? c : mine; }
        if (sum == G) break;
        __builtin_amdgcn_s_sleep(1);
        if ((++sp & 255u) == 0u) { if (xb_ld(&bar[XB_TMO])) break; if (sp > XB_SPIN_CAP) { atomicAdd(&bar[XB_TMO], 1u); break; } }
    }
    nloc = mine > 0u ? mine : 1u; nx = cnt > 0u ? cnt : 1u;
}

__device__ __forceinline__ void xcd_barrier(const XcdBarrier& b) {
    asm volatile("s_waitcnt vmcnt(0)" ::: "memory");
    __syncthreads();
    if (threadIdx.x == 0) {
        unsigned* bar = b.bar;
        __builtin_amdgcn_s_waitcnt(0);
        unsigned nloc = b.st[0], nx = b.st[1];
        if (nloc == 0u) { xcd_barrier_complete(bar, b.x, nloc, nx); b.st[0] = nloc; b.st[1] = nx; }
        const unsigned old = xb_add(&bar[XB_XSUB(b.x)], 1u);
        const unsigned gen = old / nloc;
        if (old + 1u == (gen + 1u) * nloc) {
            __builtin_amdgcn_fence(__ATOMIC_RELEASE, "agent");
            asm volatile("s_waitcnt vmcnt(0)" ::: "memory");
            const unsigned og = xb_add(&bar[XB_TOP], 1u);
            const unsigned tg = og / nx;
            if (og + 1u == (tg + 1u) * nx) xb_add(&bar[XB_TOPGEN], 1u);
            else XB_SPIN(xb_ld(&bar[XB_TOPGEN]) == tg, bar);
            __builtin_amdgcn_fence(__ATOMIC_ACQUIRE, "agent");
            xb_add(&bar[XB_XGEN(b.x)], 1u);
            asm volatile("s_waitcnt vmcnt(0)" ::: "memory");
        } else {
            XB_SPIN(xb_ld(&bar[XB_XGEN(b.x)]) == gen, bar);
            __builtin_amdgcn_fence(__ATOMIC_ACQUIRE, "agent");
            asm volatile("s_waitcnt vmcnt(0)" ::: "memory");
        }
    }
    __syncthreads();
}

struct Frame {
    LAS unsigned char* lds;
    volatile LAS unsigned* MISC;
    gu32* ctl;
    int tid, lane, wave, vcu, G;
};
struct Args { const float* in[15]; float* out; unsigned char* ws; int ph_lo, ph_hi, chunk, pad; };
#define P_xp (A.in[0])
#define P_xs (A.in[1])
#define P_w_in (A.in[2])
#define P_b_gates (A.in[3])
#define P_mh_norm_w (A.in[4])
#define P_q_norm_w (A.in[5])
#define P_k_norm_w (A.in[6])
#define P_w_out (A.in[7])
#define P_norm1_w (A.in[8])
#define P_norm2_w (A.in[9])
#define P_w_up (A.in[10])
#define P_conv_w (A.in[11])
#define P_conv_b (A.in[12])
#define P_w_down (A.in[13])
#define P_final_norm_w (A.in[14])
#define P_out (A.out)
#define P_WIN ((bf16*)(A.ws + WS_WIN))
#define P_WOUT ((bf16*)(A.ws + WS_WOUT))
#define P_WUP ((bf16*)(A.ws + WS_WUP))
#define P_WDN ((bf16*)(A.ws + WS_WDN))
#define P_KV ((bf16*)(A.ws + WS_KV))
#define P_XN ((bf16*)(A.ws + WS_XN))
#define P_MIX ((bf16*)(A.ws + WS_MIX))
#define P_MK ((bf16*)(A.ws + WS_MK))
#define P_MV ((bf16*)(A.ws + WS_MV))
#define P_MO ((bf16*)(A.ws + WS_MO))
#define P_U ((bf16*)(A.ws + WS_U))
#define P_ACT ((bf16*)(A.ws + WS_ACT))
#define P_ROPE ((float*)(A.ws + WS_ROPE))
#define P_PART1 ((float*)(A.ws + WS_PART1))
#define P_PART2 ((float*)(A.ws + WS_PART2))
#define P_GT ((float*)(A.ws + WS_G))
#define P_HF ((float*)(A.ws + WS_HF))
__device__ __constant__ float ROPE_INV[16] = {1.0f, 0.5623413251903491f, 0.31622776601683794f, 0.1778279410038923f, 0.1f, 0.05623413251903491f, 0.03162277660168379f, 0.01778279410038923f,
                                              0.01f, 0.005623413251903491f, 0.003162277660168379f, 0.001778279410038923f, 0.001f, 0.0005623413251903491f, 0.00031622776601683794f, 0.0001778279410038923f};
constexpr float C2Q = 0.125f * 1.4426950408889634f;

__device__ __forceinline__ float wave_sum(float v) {
#pragma unroll
    for (int o = 1; o < 64; o <<= 1) v += __shfl_xor(v, o);
    return v;
}
__device__ __forceinline__ void transpose_item(const float* src, int sstride, const float* kscale, bf16* dst, int dpitch, int k0, LAS float* scr, int lane) {
#pragma unroll 8
    for (int i = 0; i < 32; ++i) { const int kk = 2 * i + (lane >> 5); float v = src[(size_t)(k0 + kk) * sstride + (lane & 31)]; if (kscale) v *= kscale[k0 + kk]; scr[kk * 33 + (lane & 31)] = v; }
    LDS_WAIT(); asm volatile("" ::: "memory");
    const int c = lane & 7;
#pragma unroll
    for (int j = 0; j < 4; ++j) { const int n = (lane >> 3) + 8 * j; const LAS float* s = scr + (8 * c) * 33 + n;
        v4u o; o.x = pk2(s[0 * 33], s[1 * 33]); o.y = pk2(s[2 * 33], s[3 * 33]); o.z = pk2(s[4 * 33], s[5 * 33]); o.w = pk2(s[6 * 33], s[7 * 33]);
        *(GAS v4u*)(dst + (size_t)n * dpitch + k0 + 8 * c) = o; }
    LDS_WAIT(); asm volatile("" ::: "memory");
}
__device__ __forceinline__ void rope_entry(float* ROPE, int e) {
    const int idx = e >> 4, i = e & 15; const int pos = idx < 256 ? idx : idx - 256;
    const float ang = (float)pos * ROPE_INV[i];
    const double TWO_PI = 6.283185307179586476925;
    const double a = (double)ang, k = rint(a * (1.0 / TWO_PI)), r = a - k * TWO_PI;
    const double x = r * 0.25, x2 = x * x;
    const double s = x * (1.0 + x2 * (-1.0 / 6 + x2 * (1.0 / 120 + x2 * (-1.0 / 5040 + x2 * (1.0 / 362880 + x2 * (-1.0 / 39916800 + x2 * (1.0 / 6227020800.0)))))));
    const double c = 1.0 + x2 * (-0.5 + x2 * (1.0 / 24 + x2 * (-1.0 / 720 + x2 * (1.0 / 40320 + x2 * (-1.0 / 3628800 + x2 * (1.0 / 479001600.0 + x2 * (-1.0 / 87178291200.0)))))));
    const double s2 = 2 * s * c, c2 = 1 - 2 * s * s, s4 = 2 * s2 * c2, c4 = 1 - 2 * s2 * s2;
    ROPE[2 * e] = (float)c4; ROPE[2 * e + 1] = (float)s4;
}
__device__ __forceinline__ void rms_row_to_bf16(const float* xrow, const float* w, bf16* orow, int lane) {
    const GAS f32x4* xr = (const GAS f32x4*)xrow + lane; const GAS f32x4* wr = (const GAS f32x4*)w + lane;
    f32x4 v[4]; float s = 0.f;
#pragma unroll
    for (int j = 0; j < 4; ++j) { v[j] = xr[64 * j]; s += (v[j].x * v[j].x + v[j].y * v[j].y) + (v[j].z * v[j].z + v[j].w * v[j].w); }
    const float rinv = 1.f / sqrtf(wave_sum(s) * (1.f / DM) + EPS);
    GAS unsigned long long* o8 = (GAS unsigned long long*)orow + lane;
#pragma unroll
    for (int j = 0; j < 4; ++j) { const f32x4 ww = wr[64 * j];
        o8[64 * j] = (unsigned long long)pk2(v[j].x * rinv * ww.x, v[j].y * rinv * ww.y) | ((unsigned long long)pk2(v[j].z * rinv * ww.z, v[j].w * rinv * ww.w) << 32); }
}
__device__ __forceinline__ void p0_prologue(Frame& F, const Args& A) {
    LAS float* scr = (LAS float*)(F.lds + RING_OFF + F.wave * 16384);
    const int gw = F.vcu * NWAVES + F.wave, NGW = F.G * NWAVES;
    constexpr int I_IN = 16 * 89, I_OUT = 16 * 32, I_UP = 16 * 176, I_DN = 44 * 32, NITEMS = I_IN + I_OUT + I_UP + I_DN;
    for (int it = gw; it < NITEMS; it += NGW) {
        int r = it;
        if (r < I_IN) { const int kb = r / 89, d0 = 32 * (r % 89);
            const int sc = d0 < 2048 ? d0 : d0 < 2560 ? 2080 + (d0 - 2048) : d0 < 2816 ? 2592 + (d0 - 2560) : 2048 + (d0 - 2816);
            transpose_item(P_w_in + sc, INC, nullptr, P_WIN + (size_t)d0 * DM, DM, 64 * kb, scr, F.lane); continue; } r -= I_IN;
        if (r < I_OUT) { const int kb = r / 32, d0 = 32 * (r % 32); transpose_item(P_w_out + d0, DM, nullptr, P_WOUT + (size_t)d0 * DM, DM, 64 * kb, scr, F.lane); continue; } r -= I_OUT;
        if (r < I_UP) { const int kb = r / 176, nb = r % 176, tile = nb >> 3, wi = nb & 7; const int sc = wi < 4 ? 128 * tile + 32 * wi : FF + 128 * tile + 32 * (wi - 4);
            transpose_item(P_w_up + sc, FF2, P_norm2_w, P_WUP + (size_t)(32 * nb) * DM, DM, 64 * kb, scr, F.lane); continue; } r -= I_UP;
        { const int kb = r / 32, d0 = 32 * (r % 32); transpose_item(P_w_down + d0, DM, nullptr, P_WDN + (size_t)d0 * FF, FF, 64 * kb, scr, F.lane); }
    }
    const int gt = gw * 64 + F.lane, NTH = NGW * 64;
    for (int i = gt; i < (INP - INC) * DM / 8; i += NTH) ((GAS v4u*)(P_WIN + (size_t)INC * DM))[i] = (v4u){0u, 0u, 0u, 0u};
    for (int e = gt; e < 320 * 16; e += NTH) rope_entry(P_ROPE, e);
    for (int m = gw; m < M; m += NGW) rms_row_to_bf16(m < T0 ? P_xp + (size_t)m * DM : P_xs + (size_t)(m - T0) * DM, P_norm1_w, P_XN + (size_t)m * DM, F.lane);
}
__device__ __forceinline__ void rope8(v4u& w, const float* nw, const float* cs, const float* sn, bool second, float outscale) {
    float x[8] = {bflo(w.x), bfhi(w.x), bflo(w.y), bfhi(w.y), bflo(w.z), bfhi(w.z), bflo(w.w), bfhi(w.w)};
    float ss = 0.f;
#pragma unroll
    for (int j = 0; j < 8; ++j) ss += x[j] * x[j];
    ss += __shfl_xor(ss, 1); ss += __shfl_xor(ss, 2); ss += __shfl_xor(ss, 4);
    const float rinv = 1.f / sqrtf(ss * (1.f / 64.f) + EPS);
    float o[8];
#pragma unroll
    for (int j = 0; j < 8; ++j) { const float y = x[j] * rinv * nw[j]; const float p = __shfl_xor(y, 2); o[j] = (second ? y * cs[j] + p * sn[j] : y * cs[j] - p * sn[j]) * outscale; }
    w.x = pk2(o[0], o[1]); w.y = pk2(o[2], o[3]); w.z = pk2(o[4], o[5]); w.w = pk2(o[6], o[7]);
}
__device__ __forceinline__ void p2_rope(Frame& F, const Args& A) {
    const int gw = F.vcu * NWAVES + F.wave, NGW = F.G * NWAVES, lane = F.lane;
    const int sub = lane & 7; const bool second = (sub & 2) != 0, colpart = sub >= 4; const int i0 = 8 * (sub & 1);
    float qw[8], kw[8];
#pragma unroll
    for (int j = 0; j < 8; ++j) { qw[j] = P_q_norm_w[8 * sub + j]; kw[j] = P_k_norm_w[8 * sub + j]; }
    for (int m = gw; m < M; m += NGW) {
        const int t = m < T0 ? m : ((m - T0) & (T1 - 1));
        const int tidx = colpart ? 256 + (t & 63) : (t >> 6);
        const GAS f32x4* tab = (const GAS f32x4*)(P_ROPE + (size_t)(tidx * 16 + i0) * 2);
        float cs[8], sn[8];
#pragma unroll
        for (int j = 0; j < 4; ++j) { const f32x4 v = tab[j]; cs[2 * j] = v.x; sn[2 * j] = v.y; cs[2 * j + 1] = v.z; sn[2 * j + 1] = v.w; }
        { GAS v4u* p = (GAS v4u*)(P_MIX + (size_t)m * DM + 512) + lane; v4u w = *p; rope8(w, qw, cs, sn, second, C2Q); *p = w; }
        if (lane < 16) { GAS v4u* p = (GAS v4u*)(P_KV + (size_t)m * 256) + lane; v4u w = *p; rope8(w, kw, cs, sn, second, 1.0f); *p = w; }
    }
}
__device__ __forceinline__ void p3_mlstm_naive(Frame& F, const Args& A) {
    LAS float* red = (LAS float*)(F.lds);
    LAS float* dred = red + 1024;
    const int tid = F.tid, dv = tid & 63, dkg = F.wave;
    for (int item = blockIdx.x; item < 17 * 8; item += F.G) {
        const int seq = item >> 3, h = item & 7;
        const int T = seq == 0 ? T0 : T1; const long rowbase = seq == 0 ? 0 : T0 + (long)(seq - 1) * T1;
        const float mhw = P_mh_norm_w[h * 64 + dv];
        for (int dir = 0; dir < 2; ++dir) {
            float C[8], nn[8]; float m = 0.f;
#pragma unroll
            for (int i = 0; i < 8; ++i) { C[i] = 0.f; nn[i] = 0.f; }
            const int gi = dir * 8 + h, gf = 16 + dir * 8 + h;
            long row = rowbase + (dir ? T - 1 : 0);
            v4u kw = *(const GAS v4u*)(P_MK + row * 512 + h * 64 + dkg * 8), qw = *(const GAS v4u*)(P_MIX + row * DM + h * 64 + dkg * 8);
            unsigned short vv = P_MV[row * 512 + h * 64 + dv]; float ig = P_GT[row * 32 + gi], fg = P_GT[row * 32 + gf];
            for (int step = 0; step < T; ++step) {
                const long rowc = row; const v4u kc = kw, qc = qw; const float vc = bf2f(vv), igc = ig, fgc = fg;
                if (step + 1 < T) { row = rowbase + (dir ? T - 2 - step : step + 1);
                    kw = *(const GAS v4u*)(P_MK + row * 512 + h * 64 + dkg * 8); qw = *(const GAS v4u*)(P_MIX + row * DM + h * 64 + dkg * 8);
                    vv = P_MV[row * 512 + h * 64 + dv]; ig = P_GT[row * 32 + gi]; fg = P_GT[row * 32 + gf]; }
                const float logf = fgc < 0.f ? fgc - log1pf(expf(fgc)) : -log1pf(expf(-fgc));
                const float m_new = fmaxf(logf + m, igc), a = expf(logf + m - m_new), b = expf(igc - m_new); m = m_new;
                const float k[8] = {bflo(kc.x), bfhi(kc.x), bflo(kc.y), bfhi(kc.y), bflo(kc.z), bfhi(kc.z), bflo(kc.w), bfhi(kc.w)};
                const float q[8] = {bflo(qc.x), bfhi(qc.x), bflo(qc.y), bfhi(qc.y), bflo(qc.z), bfhi(qc.z), bflo(qc.w), bfhi(qc.w)};
                float pn = 0.f, pd = 0.f;
#pragma unroll
                for (int i = 0; i < 8; ++i) { const float bk = b * k[i]; C[i] = a * C[i] + bk * vc; nn[i] = a * nn[i] + bk; pn += q[i] * C[i]; pd += q[i] * nn[i]; }
                const int buf = step & 1; red[buf * 512 + dkg * 64 + dv] = pn; if (dv == 0) dred[buf * 8 + dkg] = pd;
                __syncthreads();
                if (tid < 64) {
                    float num = 0.f, den = 0.f;
#pragma unroll
                    for (int g = 0; g < 8; ++g) { num += red[buf * 512 + g * 64 + dv]; den += dred[buf * 8 + g]; }
                    const float hval = num / fmaxf(fabsf(den), expf(-m));
                    if (dir == 0) P_HF[rowc * 512 + h * 64 + dv] = hval;
                    else { const float hs = hval + P_HF[rowc * 512 + h * 64 + dv]; const float ss = wave_sum(hs * hs);
                        const float y = hs / sqrtf(ss * (1.f / 64.f) + EPS) * mhw; const float mo = bf2f(P_MO[rowc * 512 + h * 64 + dv]);
                        P_MIX[rowc * DM + h * 64 + dv] = (bf16)f2bf(y / (1.f + expf(-mo))); }
                }
            }
            __syncthreads();
        }
    }
}
__device__ __forceinline__ void unpack8(const v4u w, float* x) { x[0] = bflo(w.x); x[1] = bfhi(w.x); x[2] = bflo(w.y); x[3] = bfhi(w.y); x[4] = bflo(w.z); x[5] = bfhi(w.z); x[6] = bflo(w.w); x[7] = bfhi(w.w); }
__device__ __forceinline__ void conv_chunk(Frame& F, const Args& A, int c) {
    const int gt = (F.vcu * NWAVES + F.wave) * 64 + F.lane, NTH = F.G * NWAVES * 64;
    const int Tseq = c == 0 ? T0 : T1;
    const v4u Z = (v4u){0u, 0u, 0u, 0u};
    for (int ti = gt; ti < 256 * 352; ti += NTH) {
        const int cg = ti % 352, seg = ti / 352, j0 = 8 * cg, tile = j0 >> 7, jj = j0 & 127;
        const int ca = tile * 256 + jj;
        float wa[3][8], wg[3][8], ba[8], bg[8];
#pragma unroll
        for (int j = 0; j < 8; ++j) {
#pragma unroll
            for (int tp = 0; tp < 3; ++tp) { wa[tp][j] = P_conv_w[tp * FF2 + j0 + j]; wg[tp][j] = P_conv_w[tp * FF2 + FF + j0 + j]; }
            ba[j] = P_conv_b[j0 + j]; bg[j] = P_conv_b[FF + j0 + j]; }
        const int r0 = seg * 64, p0 = r0 & (Tseq - 1);
        const bf16* Ua = P_U + (size_t)r0 * FF2 + ca; const bf16* Ug = Ua + 128;
        v4u pa = Z, pg = Z;
        if (p0 > 0) { pa = *(const GAS v4u*)(Ua - FF2); pg = *(const GAS v4u*)(Ug - FF2); }
        v4u cua = *(const GAS v4u*)Ua, cug = *(const GAS v4u*)Ug;
        for (int i = 0; i < 64; ++i) {
            v4u na = Z, ng = Z;
            if (i < 63 || p0 + 64 < Tseq) { na = *(const GAS v4u*)(Ua + (size_t)(i + 1) * FF2); ng = *(const GAS v4u*)(Ug + (size_t)(i + 1) * FF2); }
            float xp[8], xc[8], xn[8], yp[8], yc[8], yn[8], o[8];
            unpack8(pa, xp); unpack8(cua, xc); unpack8(na, xn); unpack8(pg, yp); unpack8(cug, yc); unpack8(ng, yn);
#pragma unroll
            for (int j = 0; j < 8; ++j) { const float a = wa[0][j] * xp[j] + wa[1][j] * xc[j] + wa[2][j] * xn[j] + ba[j];
                const float g = wg[0][j] * yp[j] + wg[1][j] * yc[j] + wg[2][j] * yn[j] + bg[j]; o[j] = a * g / (1.f + expf(-g)); }
            v4u w; w.x = pk2(o[0], o[1]); w.y = pk2(o[2], o[3]); w.z = pk2(o[4], o[5]); w.w = pk2(o[6], o[7]);
            *(GAS v4u*)(P_ACT + (size_t)(r0 + i) * FF + j0) = w;
            pa = cua; pg = cug; cua = na; cug = ng;
        }
    }
}
__device__ __forceinline__ void final_norm(Frame& F, const Args& A) {
    const int gw = F.vcu * NWAVES + F.wave, NGW = F.G * NWAVES, lane = F.lane;
    for (int m = gw; m < M; m += NGW) {
        const float ss = wave_sum(lane < 16 ? P_PART2[(size_t)m * 16 + lane] : 0.f);
        const float rinv = 1.f / sqrtf(ss * (1.f / DM) + EPS);
        GAS f32x4* row = (GAS f32x4*)(P_out + (size_t)m * DM) + lane; const GAS f32x4* wr = (const GAS f32x4*)P_final_norm_w + lane;
#pragma unroll
        for (int j = 0; j < 4; ++j) { const f32x4 v = row[64 * j], w = wr[64 * j]; row[64 * j] = v * rinv * w; }
    }
}

#ifndef MK_FUSED
#define MK_FUSED 0
#endif
constexpr int NPH = 10;
__global__ void __launch_bounds__(NWAVES * 64, 2) enc_fwd(Args args) {
    extern __shared__ __attribute__((aligned(16))) unsigned char lds[];
    Frame F;
    F.lds = (LAS unsigned char*)lds;
    F.MISC = (volatile LAS unsigned*)(F.lds + MISC_OFF);
    F.tid = threadIdx.x; F.lane = F.tid & 63; F.wave = __builtin_amdgcn_readfirstlane(F.tid >> 6);
    F.G = gridDim.x; { const int bx = blockIdx.x; F.vcu = (F.G % 8 == 0) ? (bx % 8) * (F.G / 8) + bx / 8 : bx; }
    const Args& A = args;
    F.ctl = (gu32*)(args.ws + WS_CTL);
    for (int u = F.tid; u < (LDS_BYTES - LDSCTL_OFF) / 4; u += NWAVES * 64) ((LAS unsigned*)(F.lds + LDSCTL_OFF))[u] = 0u;
    __syncthreads();
    const int lo = args.ph_lo, hi = args.ph_hi;
    XcdBarrier bar; bar.bar = (unsigned*)(F.ctl + CW_BAR); bar.x = 0; bar.st = nullptr;
    if (hi - lo > 1) bar = xcd_barrier_post((unsigned*)(F.ctl + CW_BAR), F.MISC + 8);
#ifndef PHMASK
#define PHMASK 0xffff
#endif
#define IN(k) (((PHMASK >> (k)) & 1) && lo <= (k) && (k) < hi)
#define SEAM(k) do { if (IN(k) && IN((k) + 1)) xcd_barrier(bar); } while (0)

    if (IN(0)) { p0_prologue(F, A); SEAM(0); }
    if (IN(1)) {
        pg8::Gemm g{P_XN, P_WIN, M, INP, DM}; pg8::StaticOrder S; S.init(M, INP, F.G, (int)blockIdx.x);
        pg8::EpiIn E{P_MIX, P_MK, P_MV, P_MO, P_KV, P_GT, P_b_gates};
        pg8::gemm_phase<pg8::EpiIn, pg8::StaticOrder, true, true>(F.lds + RING_OFF, g, S, E);
        SEAM(1);
    }
    if (IN(2)) { p2_rope(F, A); SEAM(2); }
    if (IN(3)) { p3_mlstm_naive(F, A); SEAM(3); }
    if (IN(4)) {
        const attn_body::UnitOrder S((int)F.G, F.vcu);
        attn_body::attn_phase<8>((char*)lds + RING_OFF, (const attn_body::bf16*)P_MIX, (const attn_body::bf16*)P_KV, (attn_body::bf16*)P_MIX, S);
        SEAM(4);
    }
    if (IN(5)) {
        pg8::Gemm g{P_MIX, P_WOUT, M, DM, DM}; pg8::StaticOrder S; S.init(M, DM, F.G, (int)blockIdx.x);
        pg8::EpiRes<true> E{P_xp, P_xs, P_out, P_XN, P_PART1, 0};
        pg8::gemm_phase<pg8::EpiRes<true>, pg8::StaticOrder, true, true>(F.lds + RING_OFF, g, S, E);
        SEAM(5);
    }
    {
        const int c = A.chunk, row_off = c * 16384;
        if (IN(6)) {
            pg8::Gemm g{P_XN + (size_t)row_off * DM, P_WUP, 16384, FF2, DM}; pg8::StaticOrder S; S.init(16384, FF2, F.G, (int)blockIdx.x);
            pg8::EpiUp E{P_U, P_PART1, row_off, FF2};
            pg8::gemm_phase<pg8::EpiUp, pg8::StaticOrder, true, true>(F.lds + RING_OFF, g, S, E);
            SEAM(6);
        }
        if (IN(7)) { conv_chunk(F, A, c); SEAM(7); }
        if (IN(8)) {
            pg8::Gemm g{P_ACT, P_WDN, 16384, DM, FF}; pg8::StaticOrder S; S.init(16384, DM, F.G, (int)blockIdx.x);
            pg8::EpiRes<false> E{P_out, P_out + (size_t)T0 * DM, P_out, nullptr, P_PART2, row_off};
            pg8::gemm_phase<pg8::EpiRes<false>, pg8::StaticOrder, true, true>(F.lds + RING_OFF, g, S, E);
            SEAM(8);
        }
    }
    if (IN(9)) final_norm(F, A);
#undef IN
#undef SEAM
}

extern "C" void kernel_launch(void* const* d_in, const int* in_sizes, int n_in, void* d_out, int out_size, void* d_ws, size_t ws_size, hipStream_t stream) {
    static int grid = 0;
    if (grid == 0) {
        if (n_in != 15 || in_sizes[0] != T0 * DM || in_sizes[1] != NSEQ1 * T1 * DM || out_size != M * DM || ws_size < WS_END) {
            fprintf(stderr, "kernel_launch: unexpected shapes (n_in %d, in0 %d, out %d, ws %zu); nothing launched\n", n_in, n_in > 0 ? in_sizes[0] : -1, out_size, ws_size); grid = -1; return; }
        int dev = 0, cus = 0, per_cu = 0;
        if (hipGetDevice(&dev) != hipSuccess || hipDeviceGetAttribute(&cus, hipDeviceAttributeMultiprocessorCount, dev) != hipSuccess) { grid = -1; return; }
        if (hipFuncSetAttribute((const void*)enc_fwd, hipFuncAttributeMaxDynamicSharedMemorySize, LDS_BYTES) != hipSuccess) { fprintf(stderr, "kernel_launch: hipFuncSetAttribute failed\n"); grid = -1; return; }
        if (hipOccupancyMaxActiveBlocksPerMultiprocessor(&per_cu, (const void*)enc_fwd, NWAVES * 64, LDS_BYTES) != hipSuccess || per_cu < 1)
            fprintf(stderr, "kernel_launch: note: occupancy query reports %d workgroups per CU\n", per_cu);
        (void)hipGetLastError();
        grid = cus;
    }
    if (grid < 0) return;
    if (hipMemsetAsync((char*)d_ws + WS_CTL, 0, CTL_ZERO_BYTES, stream) != hipSuccess) { fprintf(stderr, "kernel_launch: hipMemsetAsync failed\n"); return; }
    Args a{};
    for (int i = 0; i < 15; ++i) a.in[i] = (const float*)d_in[i];
    a.out = (float*)d_out; a.ws = (unsigned char*)d_ws;
#if MK_FUSED
    a.ph_lo = 0; a.ph_hi = NPH;
    hipLaunchKernelGGL(enc_fwd, dim3(grid), dim3(NWAVES * 64), LDS_BYTES, stream, a);
#else
    for (int ph = 0; ph < 6; ++ph) { a.ph_lo = ph; a.ph_hi = ph + 1; hipLaunchKernelGGL(enc_fwd, dim3(grid), dim3(NWAVES * 64), LDS_BYTES, stream, a); }
    for (int c = 0; c < 3; ++c) for (int ph = 6; ph < 9; ++ph) { a.ph_lo = ph; a.ph_hi = ph + 1; a.chunk = c; hipLaunchKernelGGL(enc_fwd, dim3(grid), dim3(NWAVES * 64), LDS_BYTES, stream, a); }
    a.ph_lo = 9; a.ph_hi = 10; a.chunk = 0; hipLaunchKernelGGL(enc_fwd, dim3(grid), dim3(NWAVES * 64), LDS_BYTES, stream, a);
#endif
    const hipError_t le = hipPeekAtLastError();
    if (le != hipSuccess) fprintf(stderr, "kernel_launch: launch failed: %s\n", hipGetErrorName(le));
}
```

```cpp
#define MK_FUSED 1
#include <hip/hip_runtime.h>
#include <hip/hip_bf16.h>
#include <cstdio>
#include <cstdint>
#include <cmath>
namespace pg8 {
#define PG8_LAS __attribute__((address_space(3)))
typedef unsigned short bf16_t;
typedef short bf16x8 __attribute__((ext_vector_type(8)));
typedef float f32x4 __attribute__((ext_vector_type(4)));
typedef unsigned u32x4 __attribute__((ext_vector_type(4)));
constexpr int BM = 256, BK = 64, HALF = 128, HTB = HALF * BK * 2  , STAGE_BYTES = 8 * HTB, NXCD = 8, WGM = 8;

__host__ __device__ __forceinline__ int lds_byte(int r, int c) { const int st = (r >> 4) * 2 + (c >> 5), rr = r & 15, cc = c & 31, ob = rr * 64 + cc * 2; return st * 1024 + (ob ^ (((ob >> 9) & 1) << 5)); }
__host__ __device__ __forceinline__ void stage_rc(int b, int& R, int& C) { const int st = b / 1024, sb = b % 1024, swz = sb ^ (((sb >> 9) & 1) << 5); R = (st >> 1) * 16 + swz / 64; C = (st & 1) * 32 + (swz % 64) / 2; }
__host__ __device__ __forceinline__ int perm32(int rho) { const int n = rho >> 4, i = rho & 15; return 8 * (i >> 2) + 4 * n + (i & 3); }

struct Unit { int pm, pn; };
struct Gemm { const bf16_t* A; const bf16_t* Bt; int M, N, K; };

struct StaticOrder {
    int nM, nN, nwg, G, c;
    __host__ __device__ void init(int M, int N, int G_, int c_) { nM = M / BM; nN = N / BM; nwg = nM * nN; G = G_; c = c_; }
    __host__ __device__ bool next(int i, Unit& u) const {
        const long L = (long)i * G + c; if (L >= nwg) return false;
        int wgid = (int)L; { const int q = nwg / NXCD, r = nwg % NXCD, xcd = wgid % NXCD, off = wgid / NXCD; wgid = (xcd < r ? xcd * (q + 1) : r * (q + 1) + (xcd - r) * q) + off; }
        const int nig = WGM * nN, gid = wgid / nig, fm = gid * WGM, gsz = (nM - fm) < WGM ? (nM - fm) : WGM;
        u.pm = fm + ((wgid % nig) % gsz); u.pn = (wgid % nig) / gsz; return true;
    }
    __device__ __forceinline__ void a_ready(const Unit&) const {}
    __device__ __forceinline__ void done(const Unit&) const {}
};

__device__ __forceinline__ unsigned cvt_pk_bf16(float lo, float hi) { unsigned r; asm volatile("v_cvt_pk_bf16_f32 %0, %1, %2" : "=v"(r) : "v"(lo), "v"(hi)); return r; }
typedef float f32x2 __attribute__((ext_vector_type(2)));
constexpr int T0_ROWS = 16384;
struct EpiIn {
    static constexpr bool PERM = true, AFTER_DRAIN = false;
    bf16_t *MIX, *MK, *MV, *MO, *KV; float* G; const float* bg;
    __device__ __forceinline__ void operator()(const f32x4 (&acc)[2][2][4][2], const Unit& u, int wr, int wc, int fr, int fq) const {
        const int row0 = u.pm * BM + wr * 64 + fr; const int pn = u.pn;
        if (pn == 11) {
            if (wc == 0) {
                const f32x4 b0 = *(const f32x4*)(bg + 8 * fq), b1 = *(const f32x4*)(bg + 8 * fq + 4);
#pragma unroll
                for (int ai = 0; ai < 2; ++ai)
#pragma unroll
                    for (int m = 0; m < 4; ++m) { float* gp = G + (size_t)(row0 + ai * HALF + m * 16) * 32 + 8 * fq;
                        *(f32x4*)gp = acc[ai][0][m][0] + b0; *(f32x4*)(gp + 4) = acc[ai][0][m][1] + b1; }
            }
            return;
        }
        bf16_t* base; int ldc; float sc = 1.f;
        if (pn < 2) { base = MIX + pn * 256; ldc = 1024; }
        else if (pn < 4) { base = MK + (pn - 2) * 256; ldc = 512; sc = 0.125f; }
        else if (pn < 6) { base = MV + (pn - 4) * 256; ldc = 512; }
        else if (pn < 8) { base = MO + (pn - 6) * 256; ldc = 512; }
        else if (pn < 10) { base = MIX + 512 + (pn - 8) * 256; ldc = 1024; }
        else { base = KV; ldc = 256; }
        const int col0 = wc * 32 + 8 * fq;
#pragma unroll
        for (int ai = 0; ai < 2; ++ai)
#pragma unroll
            for (int m = 0; m < 4; ++m) { bf16_t* rowp = base + (size_t)(row0 + ai * HALF + m * 16) * ldc + col0;
#pragma unroll
                for (int bj = 0; bj < 2; ++bj) { const f32x4 v0 = acc[ai][bj][m][0] * sc, v1 = acc[ai][bj][m][1] * sc;
                    u32x4 w; w.x = cvt_pk_bf16(v0[0], v0[1]); w.y = cvt_pk_bf16(v0[2], v0[3]); w.z = cvt_pk_bf16(v1[0], v1[1]); w.w = cvt_pk_bf16(v1[2], v1[3]);
                    *(u32x4*)(rowp + bj * HALF) = w; } }
    }
};
template <bool WRITE_B> struct EpiRes {
    static constexpr bool PERM = false, AFTER_DRAIN = false;
    const float* base0; const float* base1; float* out; bf16_t* xb; float* part; int row_off;
    __device__ __forceinline__ void operator()(const f32x4 (&acc)[2][2][4][2], const Unit& u, int wr, int wc, int fr, int fq) const {
        typedef unsigned u32x2v __attribute__((ext_vector_type(2)));
#pragma unroll
        for (int ai = 0; ai < 2; ++ai)
#pragma unroll
            for (int m = 0; m < 4; ++m) {
                const int r = row_off + u.pm * BM + ai * HALF + wr * 64 + m * 16 + fr;
                const float* brow = (r < T0_ROWS) ? base0 + (size_t)r * 1024 : base1 + (size_t)(r - T0_ROWS) * 1024;
                float ss = 0.f;
#pragma unroll
                for (int bj = 0; bj < 2; ++bj)
#pragma unroll
                    for (int n = 0; n < 2; ++n) { const int col = u.pn * BM + bj * HALF + wc * 32 + n * 16 + 4 * fq;
                        const f32x4 o = *(const f32x4*)(brow + col) + acc[ai][bj][m][n];
                        *(f32x4*)(out + (size_t)r * 1024 + col) = o; ss += (o[0] * o[0] + o[1] * o[1]) + (o[2] * o[2] + o[3] * o[3]);
                        if (WRITE_B) { u32x2v w; w.x = cvt_pk_bf16(o[0], o[1]); w.y = cvt_pk_bf16(o[2], o[3]); *(u32x2v*)(xb + (size_t)r * 1024 + col) = w; } }
                ss += __shfl_xor(ss, 16); ss += __shfl_xor(ss, 32);
                if (fq == 0) part[(size_t)r * 16 + u.pn * 4 + wc] = ss;
            }
    }
};
struct EpiUp {
    static constexpr bool PERM = true, AFTER_DRAIN = false;
    bf16_t* U; const float* part; int row_off; int ldu;
    __device__ __forceinline__ void operator()(const f32x4 (&acc)[2][2][4][2], const Unit& u, int wr, int wc, int fr, int fq) const {
        const int col0 = u.pn * BM + wc * 32 + 8 * fq;
#pragma unroll
        for (int ai = 0; ai < 2; ++ai)
#pragma unroll
            for (int m = 0; m < 4; ++m) { const int rl = u.pm * BM + ai * HALF + wr * 64 + m * 16 + fr;
                const f32x4* pp = (const f32x4*)(part + (size_t)(row_off + rl) * 16); const f32x4 a = pp[0], b = pp[1], c = pp[2], d = pp[3];
                const float ss = ((a[0] + a[1]) + (a[2] + a[3])) + ((b[0] + b[1]) + (b[2] + b[3])) + ((c[0] + c[1]) + (c[2] + c[3])) + ((d[0] + d[1]) + (d[2] + d[3]));
                const float rinv = 1.0f / sqrtf(ss * (1.0f / 1024.0f) + 1e-6f);
                bf16_t* rowp = U + (size_t)rl * ldu + col0;
#pragma unroll
                for (int bj = 0; bj < 2; ++bj) { const f32x4 v0 = acc[ai][bj][m][0] * rinv, v1 = acc[ai][bj][m][1] * rinv;
                    u32x4 w; w.x = cvt_pk_bf16(v0[0], v0[1]); w.y = cvt_pk_bf16(v0[2], v0[3]); w.z = cvt_pk_bf16(v1[0], v1[1]); w.w = cvt_pk_bf16(v1[2], v1[3]);
                    *(u32x4*)(rowp + bj * HALF) = w; } }
    }
};

template <class Epi, class Sched, bool ALIGN_EPI = false, bool SP2 = false>
__device__ __forceinline__ void gemm_phase(PG8_LAS unsigned char* lds, const Gemm g, const Sched& S, const Epi& E) {
    const int tid = threadIdx.x, wid = __builtin_amdgcn_readfirstlane(tid >> 6), lane = tid & 63, wr = wid >> 2, wc = wid & 3, fr = lane & 15, fq = lane >> 4;
    const int K = g.K, nt = K / BK;
    unsigned voffA[2], voffB[2];
#pragma unroll
    for (int i = 0; i < 2; ++i) { int R, C; stage_rc(tid * 16 + i * 8192, R, C); const int Rb = Epi::PERM ? ((R & ~31) + perm32(R & 31)) : R;
        voffA[i] = (unsigned)(R * K + C) * 2u; voffB[i] = (unsigned)(Rb * K + C) * 2u; }
    const size_t kstep = (size_t)(BK * 2);
    const size_t hstep = (size_t)HALF * K * 2;
    const size_t tstep = 2 * hstep;
    const unsigned ldsw = (unsigned)wid * 1024u;
    const int aoff = lds_byte(wr * 64 + fr, fq * 8), boff = lds_byte(wc * 32 + fr, fq * 8);
#define PG8_SA(b, h) (((b) * 2 + (h)) * HTB)
#define PG8_SB(b, h) ((4 + (b) * 2 + (h)) * HTB)
#define PG8_STAGE(bufoff, gbase, voff) do { _Pragma("unroll") for (int _i = 0; _i < 2; ++_i) \
        __builtin_amdgcn_global_load_lds((const unsigned*)((const char*)(gbase) + (voff)[_i]), (PG8_LAS unsigned*)(lds + (bufoff) + ldsw + _i * 8192), 16, 0, 0); } while (0)
#define PG8_LDA(dst, b, h) do { _Pragma("unroll") for (int m = 0; m < 4; ++m) _Pragma("unroll") for (int k = 0; k < 2; ++k) dst[m][k] = *(const PG8_LAS bf16x8*)(lds + PG8_SA(b, h) + aoff + m * 2048 + k * 1024); } while (0)
#define PG8_LDB(dst, b, h) do { _Pragma("unroll") for (int n = 0; n < 2; ++n) _Pragma("unroll") for (int k = 0; k < 2; ++k) dst[n][k] = *(const PG8_LAS bf16x8*)(lds + PG8_SB(b, h) + boff + n * 2048 + k * 1024); } while (0)
#define PG8_MMA(ai, bj, At, Bt) do { __builtin_amdgcn_s_setprio(1); _Pragma("unroll") for (int m = 0; m < 4; ++m) _Pragma("unroll") for (int n = 0; n < 2; ++n) _Pragma("unroll") for (int k = 0; k < 2; ++k) \
        acc[ai][bj][m][n] = __builtin_amdgcn_mfma_f32_16x16x32_bf16(Bt[n][k], At[m][k], acc[ai][bj][m][n], 0, 0, 0); __builtin_amdgcn_s_setprio(0); } while (0)
#define PG8_WAIT_V(n) asm volatile("s_waitcnt vmcnt(" #n ")" ::: "memory")
#define PG8_WAIT_L(n) asm volatile("s_waitcnt lgkmcnt(" #n ")" ::: "memory")
#define PG8_BAR __builtin_amdgcn_s_barrier()
#define PG8_SCHED __builtin_amdgcn_sched_barrier(0)
    Unit cur, nxt; int ui = 0;
    if (!S.next(0, cur)) return;
    f32x4 acc[2][2][4][2];
#pragma unroll
    for (int a = 0; a < 2; ++a)
#pragma unroll
        for (int b = 0; b < 2; ++b)
#pragma unroll
            for (int m = 0; m < 4; ++m)
#pragma unroll
                for (int n = 0; n < 2; ++n) acc[a][b][m][n] = (f32x4){0.f, 0.f, 0.f, 0.f};
    bf16x8 At[4][2], B0[2][2], B1[2][2];
    const char* cA = (const char*)g.A + (size_t)cur.pm * tstep; const char* cB = (const char*)g.Bt + (size_t)cur.pn * tstep;
    S.a_ready(cur);
    if constexpr (SP2) {
        PG8_STAGE(PG8_SB(0, 0), cB, voffB); PG8_STAGE(PG8_SB(0, 1), cB + hstep, voffB); PG8_STAGE(PG8_SA(0, 0), cA, voffA); PG8_STAGE(PG8_SA(0, 1), cA + hstep, voffA);
        if (wr == 1) PG8_BAR;
        PG8_WAIT_V(2); PG8_BAR;
        PG8_STAGE(PG8_SB(1, 0), cB + kstep, voffB); PG8_STAGE(PG8_SA(1, 0), cA + kstep, voffA); PG8_STAGE(PG8_SB(1, 1), cB + hstep + kstep, voffB);
        PG8_WAIT_V(6); PG8_BAR;
    } else {
        PG8_STAGE(PG8_SB(0, 0), cB, voffB); PG8_STAGE(PG8_SA(0, 0), cA, voffA); PG8_STAGE(PG8_SB(0, 1), cB + hstep, voffB); PG8_STAGE(PG8_SA(0, 1), cA + hstep, voffA);
        if (wr == 1) PG8_BAR;
        PG8_WAIT_V(4); PG8_BAR;
        PG8_STAGE(PG8_SB(1, 0), cB + kstep, voffB); PG8_STAGE(PG8_SA(1, 0), cA + kstep, voffA); PG8_STAGE(PG8_SB(1, 1), cB + hstep + kstep, voffB);
        PG8_WAIT_V(6); PG8_BAR;
    }
    for (;;) {
        const bool has_next = S.next(ui + 1, nxt);
        const char* nA = has_next ? (const char*)g.A + (size_t)nxt.pm * tstep : cA; const char* nB = has_next ? (const char*)g.Bt + (size_t)nxt.pn * tstep : cB;
        for (int t = 0; t < nt; t += 2) {
            const bool last = (t == nt - 2);
            const char* a1 = cA + (size_t)(t + 1) * kstep;
            const char* a2 = last ? nA : cA + (size_t)(t + 2) * kstep; const char* b2 = last ? nB : cB + (size_t)(t + 2) * kstep;
            const char* a3 = a2 + kstep; const char* b3 = b2 + kstep;
            if (last && has_next) S.a_ready(nxt);
            if constexpr (SP2) {
            PG8_LDB(B0, 0, 0); PG8_LDB(B1, 0, 1); PG8_SCHED; PG8_LDA(At, 0, 0); PG8_STAGE(PG8_SA(1, 1), a1 + hstep, voffA);
            PG8_WAIT_V(8); PG8_WAIT_L(0); PG8_BAR; PG8_MMA(0, 0, At, B0); PG8_MMA(0, 1, At, B1); PG8_BAR; PG8_SCHED;
            PG8_LDA(At, 0, 1); PG8_STAGE(PG8_SB(0, 0), b2, voffB); PG8_STAGE(PG8_SB(0, 1), b2 + hstep, voffB); PG8_STAGE(PG8_SA(0, 0), a2, voffA);
            PG8_WAIT_V(8); PG8_WAIT_L(0); PG8_BAR; PG8_MMA(1, 0, At, B0); PG8_MMA(1, 1, At, B1); PG8_BAR; PG8_SCHED;
            PG8_LDB(B0, 1, 0); PG8_LDB(B1, 1, 1); PG8_SCHED; PG8_LDA(At, 1, 0); PG8_STAGE(PG8_SA(0, 1), a2 + hstep, voffA);
            PG8_WAIT_V(8); PG8_WAIT_L(0); PG8_BAR; PG8_MMA(0, 0, At, B0); PG8_MMA(0, 1, At, B1); PG8_BAR; PG8_SCHED;
            PG8_LDA(At, 1, 1); PG8_STAGE(PG8_SB(1, 0), b3, voffB); PG8_STAGE(PG8_SB(1, 1), b3 + hstep, voffB); PG8_STAGE(PG8_SA(1, 0), a3, voffA);
            PG8_WAIT_V(8); PG8_WAIT_L(0); PG8_BAR; PG8_MMA(1, 0, At, B0); PG8_MMA(1, 1, At, B1); PG8_BAR; PG8_SCHED;
            } else {
            PG8_LDB(B0, 0, 0); PG8_SCHED; PG8_LDA(At, 0, 0); PG8_STAGE(PG8_SA(1, 1), a1 + hstep, voffA);
            PG8_WAIT_L(8); PG8_BAR; PG8_WAIT_L(0); PG8_MMA(0, 0, At, B0); PG8_BAR; PG8_SCHED;
            PG8_LDB(B1, 0, 1); PG8_STAGE(PG8_SB(0, 0), b2, voffB);
            PG8_BAR; PG8_WAIT_L(0); PG8_MMA(0, 1, At, B1); PG8_BAR;
            PG8_LDA(At, 0, 1); PG8_STAGE(PG8_SA(0, 0), a2, voffA);
            PG8_BAR; PG8_WAIT_L(0); PG8_MMA(1, 0, At, B0); PG8_BAR; PG8_SCHED;
            PG8_STAGE(PG8_SB(0, 1), b2 + hstep, voffB);
            PG8_WAIT_V(6); PG8_BAR; PG8_MMA(1, 1, At, B1); PG8_BAR;
            PG8_LDB(B0, 1, 0); PG8_SCHED; PG8_LDA(At, 1, 0); PG8_STAGE(PG8_SA(0, 1), a2 + hstep, voffA);
            PG8_WAIT_L(8); PG8_BAR; PG8_WAIT_L(0); PG8_MMA(0, 0, At, B0); PG8_BAR; PG8_SCHED;
            PG8_LDB(B1, 1, 1); PG8_STAGE(PG8_SB(1, 0), b3, voffB);
            PG8_BAR; PG8_WAIT_L(0); PG8_MMA(0, 1, At, B1); PG8_BAR;
            PG8_LDA(At, 1, 1); PG8_STAGE(PG8_SA(1, 0), a3, voffA);
            PG8_BAR; PG8_WAIT_L(0); PG8_MMA(1, 0, At, B0); PG8_BAR; PG8_SCHED;
            PG8_STAGE(PG8_SB(1, 1), b3 + hstep, voffB);
            PG8_WAIT_V(6); PG8_BAR; PG8_MMA(1, 1, At, B1); PG8_BAR;
            }
        }
        if constexpr (ALIGN_EPI) { if (wr == 0) PG8_BAR; }
        if constexpr (!Epi::AFTER_DRAIN) { E(acc, cur, wr, wc, fr, fq); S.done(cur); }
        if (!has_next) break;
#pragma unroll
        for (int a = 0; a < 2; ++a)
#pragma unroll
            for (int b = 0; b < 2; ++b)
#pragma unroll
                for (int m = 0; m < 4; ++m)
#pragma unroll
                    for (int n = 0; n < 2; ++n) acc[a][b][m][n] = (f32x4){0.f, 0.f, 0.f, 0.f};
        cur = nxt; cA = nA; cB = nB; ++ui;
        if constexpr (ALIGN_EPI) { if (wr == 1) PG8_BAR; }
    }
    PG8_WAIT_V(0);
    if constexpr (!ALIGN_EPI) { if (wr == 0) PG8_BAR; }
    PG8_BAR;
    if constexpr (Epi::AFTER_DRAIN) { E.fused(acc, cur, wr, wc, fr, fq, lds, wid, lane); S.done(cur); }
#undef PG8_SA
#undef PG8_SB
#undef PG8_STAGE
#undef PG8_LDA
#undef PG8_LDB
#undef PG8_MMA
#undef PG8_WAIT_V
#undef PG8_WAIT_L
#undef PG8_BAR
#undef PG8_SCHED
}
}

namespace attn_body {
using bf16=__hip_bfloat16;
using bf16x8=__attribute__((ext_vector_type(8)))short;
using s16x4=__attribute__((ext_vector_type(4)))short;
using f32x16=__attribute__((ext_vector_type(16)))float;
using u32x4=__attribute__((ext_vector_type(4)))unsigned;
constexpr int D=64,QP=1024,KVP=256;
constexpr int NW=8,QBLK=32,QB=QBLK*NW,KVBLK=64;
constexpr int ATTN_UNIT_ROWS=QB;
__device__ __forceinline__ int crow(int r,int hi){return (r&3)+8*(r>>2)+4*hi;}
#define SBAR() __builtin_amdgcn_sched_barrier(0)
__device__ __forceinline__ void cmask(f32x16&p0,f32x16&p1,int jb,int qrel,int hi){
  const float NEG=-INFINITY; int kb=64*jb+4*hi;
  #pragma unroll
  for(int r=0;r<16;++r){int kv=kb+(r&3)+8*(r>>2); if(kv>qrel)p0[r]=NEG; if(kv+32>qrel)p1[r]=NEG;}
}

constexpr int NSLOT=3, SLOTB=8192;
constexpr int LDS_K=0, LDS_V=NSLOT*SLOTB, LDS_WS=2*NSLOT*SLOTB, LDS_OST=LDS_WS+NW*64*4, LDS_BYTES=LDS_OST+NW*4096;
constexpr float C2=0.125f*1.4426950408889634f;
__device__ __forceinline__ void glds16(const void*gsrc,unsigned lds_dst){unsigned keep;
  asm volatile("s_mov_b32 %0, m0\n\ts_mov_b32 m0, %2\n\ts_nop 0\n\tglobal_load_lds_dwordx4 %1, off\n\ts_mov_b32 m0, %0":"=&s"(keep):"v"(gsrc),"s"(lds_dst):"memory");}
__device__ __forceinline__ float max3f(float a,float b,float c){float r;asm("v_max3_f32 %0, %1, %2, %3":"=v"(r):"v"(a),"v"(b),"v"(c));return r;}
__device__ __forceinline__ float max2f(float a,float b){float r;asm("v_max_f32_e32 %0, %1, %2":"=v"(r):"v"(a),"v"(b));return r;}
__device__ __forceinline__ float fadd_s(float a,float b){float r;asm("v_add_f32_e32 %0, %1, %2":"=v"(r):"v"(a),"v"(b));return r;}
__device__ __forceinline__ float fsub_s(float a,float b){float r;asm("v_sub_f32_e32 %0, %1, %2":"=v"(r):"v"(a),"v"(b));return r;}
typedef float f32x2_t __attribute__((ext_vector_type(2))); typedef __bf16 bf16x2_t __attribute__((ext_vector_type(2)));
__device__ __forceinline__ unsigned cvtpk_s(float lo,float hi){f32x2_t v={lo,hi};bf16x2_t b=__builtin_convertvector(v,bf16x2_t);return __builtin_bit_cast(unsigned,b);}
#define WAIT_BAR(N) asm volatile("s_waitcnt vmcnt(" #N ") lgkmcnt(0)\n\ts_barrier":::"memory")

__device__ __forceinline__ void qkt(f32x16&p0,f32x16&p1,const char*Kslot,const bf16x8*qr,const f32x16&negm,int r32,int hi){
  const char*kb=Kslot+hi*1024+r32*16;
  #pragma unroll
  for(int d0=0;d0<4;++d0){
    const bf16x8 b0=*reinterpret_cast<const bf16x8*>(kb+d0*2048);
    const bf16x8 b1=*reinterpret_cast<const bf16x8*>(kb+d0*2048+512);
    if(d0==0){p0=__builtin_amdgcn_mfma_f32_32x32x16_bf16(b0,qr[0],negm,0,0,0);p1=__builtin_amdgcn_mfma_f32_32x32x16_bf16(b1,qr[0],negm,0,0,0);}
    else{p0=__builtin_amdgcn_mfma_f32_32x32x16_bf16(b0,qr[d0],p0,0,0,0);p1=__builtin_amdgcn_mfma_f32_32x32x16_bf16(b1,qr[d0],p1,0,0,0);}}
}
typedef __attribute__((address_space(3))) const char* lds_cptr;
typedef short v4i16_t __attribute__((ext_vector_type(4)));
__device__ __forceinline__ void kload8(bf16x8*kf,lds_cptr kp){
  kf[0]=*(const __attribute__((address_space(3))) bf16x8*)(kp);      kf[1]=*(const __attribute__((address_space(3))) bf16x8*)(kp+512);
  kf[2]=*(const __attribute__((address_space(3))) bf16x8*)(kp+2048); kf[3]=*(const __attribute__((address_space(3))) bf16x8*)(kp+2560);
  kf[4]=*(const __attribute__((address_space(3))) bf16x8*)(kp+4096); kf[5]=*(const __attribute__((address_space(3))) bf16x8*)(kp+4608);
  kf[6]=*(const __attribute__((address_space(3))) bf16x8*)(kp+6144); kf[7]=*(const __attribute__((address_space(3))) bf16x8*)(kp+6656);
}
__device__ __forceinline__ void kload2(bf16x8*kf,lds_cptr kp,int j){ kf[2*j]=*(const __attribute__((address_space(3))) bf16x8*)(kp+j*2048); kf[2*j+1]=*(const __attribute__((address_space(3))) bf16x8*)(kp+j*2048+512); }
__device__ __forceinline__ s16x4 vtr(lds_cptr p){ return __builtin_bit_cast(s16x4,__builtin_amdgcn_ds_read_tr16_b64_v4i16((__attribute__((address_space(3))) v4i16_t*)p)); }
__device__ __forceinline__ float rowmax(const f32x16&p0,const f32x16&p1){
  float a=max3f(p0[0],p0[1],p1[0]),b=max3f(p0[2],p0[3],p1[1]);a=max3f(a,p1[2],p1[3]);
  #pragma unroll
  for(int r=4;r<16;r+=4){a=max3f(a,p0[r],p0[r+1]);b=max3f(b,p0[r+2],p0[r+3]);a=max3f(a,p1[r],p1[r+1]);b=max3f(b,p1[r+2],p1[r+3]);}
  const float m=max2f(a,b);
  auto rr=__builtin_amdgcn_permlane32_swap(__float_as_uint(m),__float_as_uint(m),false,false);
  return max2f(__uint_as_float(rr[0]),__uint_as_float(rr[1]));
}
__device__ __forceinline__ void pv(f32x16*o,int vb,bf16x8 pa0,bf16x8 pa1,bf16x8 pa2,bf16x8 pa3){
  #pragma unroll
  for(int d0=0;d0<2;++d0){s16x4 lo[4],hi[4];
    #pragma unroll
    for(int ks=0;ks<4;++ks){
      asm volatile("ds_read_b64_tr_b16 %0,%1 offset:%c2":"=&v"(lo[ks]):"v"(vb),"i"(d0*4096+ks*1024):"memory");
      asm volatile("ds_read_b64_tr_b16 %0,%1 offset:%c2":"=&v"(hi[ks]):"v"(vb),"i"(d0*4096+ks*1024+512):"memory");}
    asm volatile("s_waitcnt lgkmcnt(0)":::"memory");SBAR();
    #define PK(k) (bf16x8){lo[k][0],lo[k][1],lo[k][2],lo[k][3],hi[k][0],hi[k][1],hi[k][2],hi[k][3]}
    o[d0]=__builtin_amdgcn_mfma_f32_32x32x16_bf16(pa0,PK(0),o[d0],0,0,0);
    o[d0]=__builtin_amdgcn_mfma_f32_32x32x16_bf16(pa1,PK(1),o[d0],0,0,0);
    o[d0]=__builtin_amdgcn_mfma_f32_32x32x16_bf16(pa2,PK(2),o[d0],0,0,0);
    o[d0]=__builtin_amdgcn_mfma_f32_32x32x16_bf16(pa3,PK(3),o[d0],0,0,0);
    #undef PK
  }
}

#ifndef ATTN_STORE16
#define ATTN_STORE16(p,v) (*(u32x4*)(p)=(v))
#endif
template<int THRL> __device__ __forceinline__ void attn_unit(long rowbase,int NT,int qcol,int kcol,int vcol,int qb,const bf16*Q,const bf16*__restrict__ K,const bf16*__restrict__ V,bf16*O,char*shm){
  const int tid=threadIdx.x,lane=tid&63,r32=lane&31,hi=lane>>5; const int wid=__builtin_amdgcn_readfirstlane(tid>>6);
  const int q0=qb*QB;
  const bf16*Qw=Q+(rowbase+q0+wid*QBLK)*QP+qcol;
  const bf16*Kh=K+rowbase*KVP+kcol,*Vh=V+rowbase*KVP+vcol;
  const unsigned lds0=(unsigned)(uintptr_t)shm;
  float*wsf=(float*)(shm+LDS_WS)+wid*64;
  const bf16*ksrc=Kh+(long)lane*KVP+wid*8;
  const bf16*vsrc=Vh+(long)(16*(wid&3)+(lane>>2))*KVP+(wid>>2)*32+(lane&3)*8;
  const unsigned kdst=lds0+LDS_K+wid*1024, vdst=lds0+LDS_V+wid*1024;
  #define DMA_K(t,slot) glds16(ksrc+(long)(t)*KVBLK*KVP,(unsigned)__builtin_amdgcn_readfirstlane(kdst+(slot)))
  #define DMA_V(t,slot) glds16(vsrc+(long)(t)*KVBLK*KVP,(unsigned)__builtin_amdgcn_readfirstlane(vdst+(slot)))
  const int vb0=(int)(lds0+LDS_V)+((lane>>4)&1)*32+(lane&3)*8+(4*hi+((lane&15)>>2))*64;
  const char*Kbase=shm+LDS_K; bf16x8 kf[8];
  const lds_cptr shm3=(lds_cptr)shm; const lds_cptr kp0=shm3+LDS_K+hi*1024+r32*16; const lds_cptr vp0=shm3+LDS_V+((lane>>4)&1)*32+(lane&3)*8+(4*hi+((lane&15)>>2))*64;
  DMA_K(0,0);DMA_V(0,0);DMA_K(1,SLOTB);
  bf16x8 qr[4];
  #pragma unroll
  for(int d0=0;d0<4;++d0)qr[d0]=*reinterpret_cast<const bf16x8*>(&Qw[(long)r32*QP+d0*16+hi*8]);
  float mhat=0.f,l_reg=0.f;f32x16 o[2];o[0]=f32x16{};o[1]=f32x16{};f32x16 negm=f32x16{};asm volatile("":"+v"(negm));
  #define CMASK(P0,P1,t) do{}while(0)
  bool resc=false;
  #define START(P0,P1) do{ const float rm=rowmax(P0,P1); resc=false; \
    { const float dl=rm; mhat=fadd_s(mhat,dl); \
      _Pragma("unroll") for(int r=0;r<16;++r){P0[r]=fsub_s(P0[r],dl);P1[r]=fsub_s(P1[r],dl);} \
      _Pragma("unroll") for(int r=0;r<16;++r)negm[r]=-mhat; asm volatile("":"+v"(negm)); } \
    _Pragma("unroll") for(int r=0;r<16;++r)P0[r]=__builtin_amdgcn_exp2f(P0[r]); }while(0)
  #define RESC() do{ if(resc){ asm volatile("s_waitcnt lgkmcnt(0)":::"memory"); \
      _Pragma("unroll") for(int d_=0;d_<2;++d_) _Pragma("unroll") for(int r=0;r<16;++r)o[d_][r]*=wsf[crow(r,hi)]; } }while(0)
  f32x16 pA0,pA1,pB0,pB1;
  int sl_prev=0,sl_cur=0,sl_next=SLOTB;
  #define ROT() do{sl_prev=sl_cur;sl_cur=sl_next;sl_next=(sl_next==(NSLOT-1)*SLOTB)?0:sl_next+SLOTB;}while(0)
  DMA_K(2,2*SLOTB);
  WAIT_BAR(3);
  qkt(pA0,pA1,Kbase,qr,negm,r32,hi);asm volatile("s_nop 15\n\ts_nop 7":"+v"(pA0),"+v"(pA1));CMASK(pA0,pA1,0);
  START(pA0,pA1);
  _Pragma("unroll") for(int r=0;r<16;++r)pA1[r]=__builtin_amdgcn_exp2f(pA1[r]);
  WAIT_BAR(0);
  DMA_K(3,0);DMA_V(1,SLOTB);
  ROT();
  kload8(kf,kp0+sl_cur);
  WAIT_BAR(2);
  s16x4 vlo[8],vhi[8]; u32x4 pw0,pw1,pw2,pw3;
  #define PKW(P,B) cvtpk_s(P[B],P[B+1])
  #define PAF(k) __builtin_bit_cast(bf16x8,pw##k)
  #define VFR(i) (bf16x8){vlo[i][0],vlo[i][1],vlo[i][2],vlo[i][3],vhi[i][0],vhi[i][1],vhi[i][2],vhi[i][3]}
  #define PIN(x) asm volatile("":"+v"(x))
  #define MX3(a,b,c) __builtin_fmaxf(__builtin_fmaxf((a),(b)),(c))
  #define GAPA(MF,A0,A1,A2,A3,W0,W1,PW) do{ MF; sacc+=A0; sacc+=A1; sacc+=A2; sacc+=A3; PIN(sacc); W0; W1; PIN(PW); SBAR(); }while(0)
  #define EX(v) __builtin_amdgcn_exp2f(v)
  #define GAPB(MF,X,B) do{ MF; X[B]=EX(X[B]); X[B+1]=EX(X[B+1]); X[B+2]=EX(X[B+2]); X[B+3]=EX(X[B+3]); PIN(X); SBAR(); }while(0)
  #define VRD(i) do{ vlo[i]=vtr(vp_+(((i)>>2)*4096+((i)&3)*1024)); vhi[i]=vtr(vp_+(((i)>>2)*4096+((i)&3)*1024+512)); }while(0)
  #define KRD(G,j) do{ if(G){ kload2(kf,kp0+sl_next,j); SBAR(); } }while(0)
  #define STEP(C0,C1,P0,P1,t,GK,GV,GL) do{ SBAR(); \
    const lds_cptr vp_=vp0+sl_prev; \
    VRD(0); SBAR(); float sacc=(P0[0]+P0[1]); \
    GAPA(C0=__builtin_amdgcn_mfma_f32_32x32x16_bf16(kf[0],qr[0],negm,0,0,0), P0[2],P0[3],P0[4],P0[5],     pw0[0]=PKW(P0,0), pw0[1]=PKW(P0,2), pw0); \
    VRD(4); SBAR(); GAPA(C1=__builtin_amdgcn_mfma_f32_32x32x16_bf16(kf[1],qr[0],negm,0,0,0), P0[6],P0[7],P0[8],P0[9],     pw0[2]=PKW(P0,4), pw0[3]=PKW(P0,6), pw0); \
    VRD(1); SBAR(); GAPA(C0=__builtin_amdgcn_mfma_f32_32x32x16_bf16(kf[2],qr[1],C0,0,0,0),   P0[10],P0[11],P0[12],P0[13], pw1[0]=PKW(P0,8), pw1[1]=PKW(P0,10), pw1); \
    VRD(5); SBAR(); GAPA(C1=__builtin_amdgcn_mfma_f32_32x32x16_bf16(kf[3],qr[1],C1,0,0,0),   P0[14],P0[15],P1[0],P1[1],   pw1[2]=PKW(P0,12),pw1[3]=PKW(P0,14), pw1); \
    VRD(2); SBAR(); GAPA(C0=__builtin_amdgcn_mfma_f32_32x32x16_bf16(kf[4],qr[2],C0,0,0,0),   P1[2],P1[3],P1[4],P1[5],     pw2[0]=PKW(P1,0), pw2[1]=PKW(P1,2), pw2); \
    VRD(6); SBAR(); GAPA(C1=__builtin_amdgcn_mfma_f32_32x32x16_bf16(kf[5],qr[2],C1,0,0,0),   P1[6],P1[7],P1[8],P1[9],     pw2[2]=PKW(P1,4), pw2[3]=PKW(P1,6), pw2); \
    VRD(3); SBAR(); GAPA(C0=__builtin_amdgcn_mfma_f32_32x32x16_bf16(kf[6],qr[3],C0,0,0,0),   P1[10],P1[11],P1[12],P1[13], pw3[0]=PKW(P1,8), pw3[1]=PKW(P1,10), pw3); \
    VRD(7); SBAR(); GAPA(C1=__builtin_amdgcn_mfma_f32_32x32x16_bf16(kf[7],qr[3],C1,0,0,0),   P1[14],P1[15],0.f,0.f,       pw3[2]=PKW(P1,12),pw3[3]=PKW(P1,14), pw3); \
    l_reg+=sacc; \
    if(GK){DMA_K((t)+3,sl_cur);} if(GV){DMA_V((t)+1,sl_next);} \
    CMASK(C0,C1,t); \
    { float a=MX3(C0[0],C0[1],C1[0]),b=MX3(C0[2],C0[3],C1[1]); a=MX3(a,C1[2],C1[3]); \
      _Pragma("unroll") for(int r=4;r<16;r+=4){a=MX3(a,C0[r],C0[r+1]);b=MX3(b,C0[r+2],C0[r+3]);a=MX3(a,C1[r],C1[r+1]);b=MX3(b,C1[r+2],C1[r+3]);} \
      float rm=__builtin_fmaxf(a,b); { auto rr=__builtin_amdgcn_permlane32_swap(__float_as_uint(rm),__float_as_uint(rm),false,false); rm=__builtin_fmaxf(__uint_as_float(rr[0]),__uint_as_float(rr[1])); } \
      resc=false; \
      if(__builtin_expect(__any(rm>(float)THRL),0)){ const float dl=__builtin_fmaxf(rm,0.f); mhat+=dl; \
        _Pragma("unroll") for(int r=0;r<16;++r){C0[r]-=dl;C1[r]-=dl;} \
        _Pragma("unroll") for(int r=0;r<16;++r)negm[r]=-mhat; asm volatile("":"+v"(negm)); \
        const float f=__builtin_amdgcn_exp2f(-dl); l_reg*=f; if(hi==0)wsf[r32]=f; resc=true; } } \
    SBAR(); \
    GAPB(o[0]=__builtin_amdgcn_mfma_f32_32x32x16_bf16(PAF(0),VFR(0),o[0],0,0,0), C0,0); \
    GAPB(o[1]=__builtin_amdgcn_mfma_f32_32x32x16_bf16(PAF(0),VFR(4),o[1],0,0,0), C0,4); \
    KRD(GL,0); GAPB(o[0]=__builtin_amdgcn_mfma_f32_32x32x16_bf16(PAF(1),VFR(1),o[0],0,0,0), C0,8); \
    KRD(GL,1); GAPB(o[1]=__builtin_amdgcn_mfma_f32_32x32x16_bf16(PAF(1),VFR(5),o[1],0,0,0), C0,12); \
    KRD(GL,2); GAPB(o[0]=__builtin_amdgcn_mfma_f32_32x32x16_bf16(PAF(2),VFR(2),o[0],0,0,0), C1,0); \
    KRD(GL,3); GAPB(o[1]=__builtin_amdgcn_mfma_f32_32x32x16_bf16(PAF(2),VFR(6),o[1],0,0,0), C1,4); \
    GAPB(o[0]=__builtin_amdgcn_mfma_f32_32x32x16_bf16(PAF(3),VFR(3),o[0],0,0,0), C1,8); \
    GAPB(o[1]=__builtin_amdgcn_mfma_f32_32x32x16_bf16(PAF(3),VFR(7),o[1],0,0,0), C1,12); \
    }while(0)
  int t=1;
  #undef CMASK
  #define CMASK(P0,P1,t) do{}while(0)
  for(;t+5<NT;t+=2){
    STEP(pB0,pB1,pA0,pA1,t,true,true,true);     WAIT_BAR(2); RESC(); ROT();
    STEP(pA0,pA1,pB0,pB1,t+1,true,true,true);   WAIT_BAR(2); RESC(); ROT();
  }
  #undef CMASK
  #define CMASK(P0,P1,t) do{}while(0)
  #define ENDW(tt) do{ if((tt)+3<NT){WAIT_BAR(2);} else if((tt)+2<NT){WAIT_BAR(1);} else {WAIT_BAR(0);} }while(0)
  for(;t+1<NT;t+=2){
    STEP(pB0,pB1,pA0,pA1,t,(t+3<NT),(t+1<NT),(t+1<NT));       ENDW(t);   RESC(); ROT();
    STEP(pA0,pA1,pB0,pB1,t+1,(t+4<NT),(t+2<NT),(t+2<NT));     ENDW(t+1); RESC(); ROT();
  }
  STEP(pB0,pB1,pA0,pA1,NT-1,false,false,false); RESC();
  { float sacc=pB0[0]+pB0[1]; _Pragma("unroll") for(int r=2;r<16;++r)sacc+=pB0[r]; _Pragma("unroll") for(int r=0;r<16;++r)sacc+=pB1[r]; l_reg+=sacc;
    pw0=(u32x4){PKW(pB0,0),PKW(pB0,2),PKW(pB0,4),PKW(pB0,6)};pw1=(u32x4){PKW(pB0,8),PKW(pB0,10),PKW(pB0,12),PKW(pB0,14)};pw2=(u32x4){PKW(pB1,0),PKW(pB1,2),PKW(pB1,4),PKW(pB1,6)};pw3=(u32x4){PKW(pB1,8),PKW(pB1,10),PKW(pB1,12),PKW(pB1,14)};
    SBAR(); pv(o,vb0+sl_cur,PAF(0),PAF(1),PAF(2),PAF(3)); }
  #undef PKW
  #undef PAF
  #undef VFR
  #undef PIN
  #undef MX3
  #undef GAPA
  #undef GAPB
  #undef EX
  #undef VRD
  #undef KRD
  #undef STEP
  #undef ENDW
  {auto rr=__builtin_amdgcn_permlane32_swap(__float_as_uint(l_reg),__float_as_uint(l_reg),false,false);l_reg=__uint_as_float(rr[0])+__uint_as_float(rr[1]);}
  if(hi==0)wsf[32+r32]=l_reg;asm volatile("s_waitcnt lgkmcnt(0)":::"memory");
  float rli[16];
  #pragma unroll
  for(int r=0;r<16;++r)rli[r]=__builtin_amdgcn_rcpf(wsf[32+crow(r,hi)]);
  bf16*Ow=O+(rowbase+q0+wid*QBLK)*QP+qcol;
  { bf16*stg=(bf16*)(shm+LDS_OST)+wid*2048;
    #pragma unroll
    for(int r=0;r<16;++r){const int orow=crow(r,hi);
      #pragma unroll
      for(int d0=0;d0<2;++d0)stg[orow*64+d0*32+r32]=__float2bfloat16(o[d0][r]*rli[r]);}
    asm volatile("s_waitcnt lgkmcnt(0)":::"memory");
    #pragma unroll
    for(int i=0;i<4;++i){const int row=i*8+(lane>>3),ch=lane&7; const u32x4 v=*(const u32x4*)(stg+row*64+ch*8); ATTN_STORE16(Ow+(long)row*QP+ch*8,v);} }
  asm volatile("s_waitcnt lgkmcnt(0)\n\ts_barrier":::"memory");
  #undef DMA_K
  #undef DMA_V
  #undef CMASK
  #undef START
  #undef RESC
  #undef ROT
}
constexpr int ATTN_LDS_BYTES=LDS_BYTES;
#undef SBAR
#undef WAIT_BAR
}

namespace attn_body {
struct AttnUnit { long rowbase; int NT, h, qb; };
struct UnitOrder {
  int vcu, G;
  __device__ __forceinline__ UnitOrder(int grid,int v):vcu(v),G(grid){}
  __device__ __forceinline__ bool next(int i,AttnUnit&u)const{
    const int v=vcu+(i/6)*G, j=i%6; if(v>=256)return false;
    if(j<2){ const int pu=2*v+j; u.rowbase=0; u.NT=256; u.h=pu>>6; u.qb=pu&63; }
    else { const int su=4*v+(j-2); u.rowbase=16384+(long)(su>>6)*2048; u.NT=32; u.h=(su>>3)&7; u.qb=su&7; }
    return true; }
};
template<int THRL=8> __device__ __forceinline__ void attn_phase(char*lds,const bf16*MIXQ,const bf16*KV,bf16*MIXO,const UnitOrder&S){
  AttnUnit u;
  for(int i=0;S.next(i,u);++i){ attn_unit<THRL>(u.rowbase,u.NT,512+u.h*64,(u.h>>2)*64,128+(u.h>>2)*64,u.qb,MIXQ,KV,KV,MIXO,lds); }
}
}

constexpr int NWAVES = 8;
constexpr int DM = 1024, T0 = 16384, NSEQ1 = 16, T1 = 2048, M = T0 + NSEQ1 * T1;
constexpr int HD = 64, NH = 8, MW = 512, INC = 2848, INP = 3072, FF = 2816, FF2 = 5632;
constexpr float EPS = 1e-6f;
static_assert(M == 49152 && M % 256 == 0 && pg8::T0_ROWS == T0, "shapes");

constexpr size_t MiB = 1u << 20;
constexpr size_t WS_CTL = 0, CTL_ZERO_BYTES = 1 * MiB;
constexpr size_t WS_WIN = 2 * MiB, WS_WOUT = 8 * MiB, WS_WUP = 10 * MiB, WS_WDN = 21 * MiB;
constexpr size_t WS_ROPE = 27 * MiB;
constexpr size_t WS_PART1 = 28 * MiB, WS_PART2 = 31 * MiB;
constexpr size_t WS_G = 34 * MiB;
constexpr size_t WS_KV = 40 * MiB;
constexpr size_t WS_XN = 64 * MiB;
constexpr size_t WS_MIX = 160 * MiB;
constexpr size_t WS_MK = 256 * MiB, WS_MV = 304 * MiB, WS_MO = 352 * MiB;
constexpr size_t WS_HF = 400 * MiB;
constexpr size_t WS_U = 160 * MiB, WS_ACT = 336 * MiB;
constexpr size_t WS_END = 496 * MiB;
constexpr int CW_BAR = 4096;

constexpr int RING_OFF = 0, RING_BYTES = 131072;
constexpr int LDSCTL_OFF = RING_BYTES, MISC_OFF = LDSCTL_OFF + 320;
constexpr int LDS_BYTES = 147456;

#define GAS __attribute__((address_space(1)))
#define LAS __attribute__((address_space(3)))
typedef unsigned short bf16;
typedef unsigned v4u __attribute__((ext_vector_type(4)));
typedef float f32x4 __attribute__((ext_vector_type(4)));
typedef GAS unsigned gu32;
#define RLX_AGENT __ATOMIC_RELAXED, __HIP_MEMORY_SCOPE_AGENT
#define LDS_WAIT() asm volatile("s_waitcnt lgkmcnt(0)" ::: "memory")
#define VM_WAIT() asm volatile("s_waitcnt vmcnt(0)" ::: "memory")
__device__ __forceinline__ unsigned f2bf(float f) { unsigned u = __builtin_bit_cast(unsigned, f); return (u + 0x7fffu + ((u >> 16) & 1u)) >> 16; }
__device__ __forceinline__ unsigned pk2(float lo, float hi) { return f2bf(lo) | (f2bf(hi) << 16); }
__device__ __forceinline__ float bf2f(unsigned short b) { return __builtin_bit_cast(float, (unsigned)b << 16); }
__device__ __forceinline__ float bflo(unsigned w) { return __builtin_bit_cast(float, w << 16); }
__device__ __forceinline__ float bfhi(unsigned w) { return __builtin_bit_cast(float, w & 0xffff0000u); }
#define XB_TMO      128
#define XB_XCNT(j)  (256  + 64 * (j))
#define XB_XSUB(j)  (1280 + 64 * (j))
#define XB_XGEN(j)  (2304 + 64 * (j))
#define XB_TOP      3328
#define XB_TOPGEN   3392
#define XCD_BAR_WORDS 3456
#define XB_SPIN_CAP (1u << 24)

__device__ __forceinline__ unsigned xb_ld(unsigned* p)              { return __hip_atomic_load(p, __ATOMIC_RELAXED, __HIP_MEMORY_SCOPE_AGENT); }
__device__ __forceinline__ unsigned xb_add(unsigned* p, unsigned v) { return __hip_atomic_fetch_add(p, v, __ATOMIC_RELAXED, __HIP_MEMORY_SCOPE_AGENT); }
__device__ __forceinline__ unsigned xb_xcc_id() { return (unsigned)__builtin_amdgcn_s_getreg((3 << 11) | 20) & 0xFu; }
#define XB_SPIN(cond, bar) do { unsigned _sp = 0; while (cond) { __builtin_amdgcn_s_sleep(1); \
    if ((++_sp & 255u) == 0u) { if (xb_ld(&(bar)[XB_TMO])) break; if (_sp > XB_SPIN_CAP) { atomicAdd(&(bar)[XB_TMO], 1u); break; } } } } while (0)

struct XcdBarrier {
    unsigned* bar; unsigned x;
    volatile LAS unsigned* st;
};

__device__ __forceinline__ XcdBarrier xcd_barrier_post(unsigned* bar, volatile LAS unsigned* st) {
    XcdBarrier b; b.bar = bar; b.x = xb_xcc_id(); b.st = st;
    if (threadIdx.x == 0) (void)xb_add(&bar[XB_XCNT(b.x)], 1u);
    return b;
}
__device__ __forceinline__ void xcd_barrier_complete(unsigned* bar, unsigned x, unsigned& nloc, unsigned& nx) {
    const unsigned G = gridDim.x * gridDim.y * gridDim.z;
    unsigned sum, cnt, mine, sp = 0u;
    for (;;) {
        sum = 0u; cnt = 0u; mine = 0u;
#pragma unroll
        for (unsigned j = 0; j < 16; ++j) { const unsigned c = xb_ld(&bar[XB_XCNT(j)]); sum += c; cnt += (c > 0u) ? 1u : 0u; mine = (j == x) ? c : mine; }
        if (sum == G) break;
        __builtin_amdgcn_s_sleep(1);
        if ((++sp & 255u) == 0u) { if (xb_ld(&bar[XB_TMO])) break; if (sp > XB_SPIN_CAP) { atomicAdd(&bar[XB_TMO], 1u); break; } }
    }
    nloc = mine > 0u ? mine : 1u; nx = cnt > 0u ? cnt : 1u;
}

__device__ __forceinline__ void xcd_barrier(const XcdBarrier& b) {
    asm volatile("s_waitcnt vmcnt(0)" ::: "memory");
    __syncthreads();
    if (threadIdx.x == 0) {
        unsigned* bar = b.bar;
        __builtin_amdgcn_s_waitcnt(0);
        unsigned nloc = b.st[0], nx = b.st[1];
        if (nloc == 0u) { xcd_barrier_complete(bar, b.x, nloc, nx); b.st[0] = nloc; b.st[1] = nx; }
        const unsigned old = xb_add(&bar[XB_XSUB(b.x)], 1u);
        const unsigned gen = old / nloc;
        if (old + 1u == (gen + 1u) * nloc) {
            __builtin_amdgcn_fence(__ATOMIC_RELEASE, "agent");
            asm volatile("s_waitcnt vmcnt(0)" ::: "memory");
            const unsigned og = xb_add(&bar[XB_TOP], 1u);
            const unsigned tg = og / nx;
            if (og + 1u == (tg + 1u) * nx) xb_add(&bar[XB_TOPGEN], 1u);
            else XB_SPIN(xb_ld(&bar[XB_TOPGEN]) == tg, bar);
            __builtin_amdgcn_fence(__ATOMIC_ACQUIRE, "agent");
            xb_add(&bar[XB_XGEN(b.x)], 1u);
            asm volatile("s_waitcnt vmcnt(0)" ::: "memory");
        } else {
            XB_SPIN(xb_ld(&bar[XB_XGEN(b.x)]) == gen, bar);
            __builtin_amdgcn_fence(__ATOMIC_ACQUIRE, "agent");
            asm volatile("s_waitcnt vmcnt(0)" ::: "memory");
        }
    }
    __syncthreads();
}

struct Frame {
    LAS unsigned char* lds;
    volatile LAS unsigned* MISC;
    gu32* ctl;
    int tid, lane, wave, vcu, G;
};
struct Args { const float* in[15]; float* out; unsigned char* ws; int ph_lo, ph_hi, chunk, pad; };
#define P_xp (A.in[0])
#define P_xs (A.in[1])
#define P_w_in (A.in[2])
#define P_b_gates (A.in[3])
#define P_mh_norm_w (A.in[4])
#define P_q_norm_w (A.in[5])
#define P_k_norm_w (A.in[6])
#define P_w_out (A.in[7])
#define P_norm1_w (A.in[8])
#define P_norm2_w (A.in[9])
#define P_w_up (A.in[10])
#define P_conv_w (A.in[11])
#define P_conv_b (A.in[12])
#define P_w_down (A.in[13])
#define P_final_norm_w (A.in[14])
#define P_out (A.out)
#define P_WIN ((bf16*)(A.ws + WS_WIN))
#define P_WOUT ((bf16*)(A.ws + WS_WOUT))
#define P_WUP ((bf16*)(A.ws + WS_WUP))
#define P_WDN ((bf16*)(A.ws + WS_WDN))
#define P_KV ((bf16*)(A.ws + WS_KV))
#define P_XN ((bf16*)(A.ws + WS_XN))
#define P_MIX ((bf16*)(A.ws + WS_MIX))
#define P_MK ((bf16*)(A.ws + WS_MK))
#define P_MV ((bf16*)(A.ws + WS_MV))
#define P_MO ((bf16*)(A.ws + WS_MO))
#define P_U ((bf16*)(A.ws + WS_U))
#define P_ACT ((bf16*)(A.ws + WS_ACT))
#define P_ROPE ((float*)(A.ws + WS_ROPE))
#define P_PART1 ((float*)(A.ws + WS_PART1))
#define P_PART2 ((float*)(A.ws + WS_PART2))
#define P_GT ((float*)(A.ws + WS_G))
#define P_HF ((float*)(A.ws + WS_HF))
__device__ __constant__ float ROPE_INV[16] = {1.0f, 0.5623413251903491f, 0.31622776601683794f, 0.1778279410038923f, 0.1f, 0.05623413251903491f, 0.03162277660168379f, 0.01778279410038923f,
                                              0.01f, 0.005623413251903491f, 0.003162277660168379f, 0.001778279410038923f, 0.001f, 0.0005623413251903491f, 0.00031622776601683794f, 0.0001778279410038923f};
constexpr float C2Q = 0.125f * 1.4426950408889634f;

__device__ __forceinline__ float wave_sum(float v) {
#pragma unroll
    for (int o = 1; o < 64; o <<= 1) v += __shfl_xor(v, o);
    return v;
}
__device__ __forceinline__ void transpose_item(const float* src, int sstride, const float* kscale, bf16* dst, int dpitch, int k0, LAS float* scr, int lane) {
#pragma unroll 8
    for (int i = 0; i < 32; ++i) { const int kk = 2 * i + (lane >> 5); float v = src[(size_t)(k0 + kk) * sstride + (lane & 31)]; if (kscale) v *= kscale[k0 + kk]; scr[kk * 33 + (lane & 31)] = v; }
    LDS_WAIT(); asm volatile("" ::: "memory");
    const int c = lane & 7;
#pragma unroll
    for (int j = 0; j < 4; ++j) { const int n = (lane >> 3) + 8 * j; const LAS float* s = scr + (8 * c) * 33 + n;
        v4u o; o.x = pk2(s[0 * 33], s[1 * 33]); o.y = pk2(s[2 * 33], s[3 * 33]); o.z = pk2(s[4 * 33], s[5 * 33]); o.w = pk2(s[6 * 33], s[7 * 33]);
        *(GAS v4u*)(dst + (size_t)n * dpitch + k0 + 8 * c) = o; }
    LDS_WAIT(); asm volatile("" ::: "memory");
}
__device__ __forceinline__ void rope_entry(float* ROPE, int e) {
    const int idx = e >> 4, i = e & 15; const int pos = idx < 256 ? idx : idx - 256;
    const float ang = (float)pos * ROPE_INV[i];
    const double TWO_PI = 6.283185307179586476925;
    const double a = (double)ang, k = rint(a * (1.0 / TWO_PI)), r = a - k * TWO_PI;
    const double x = r * 0.25, x2 = x * x;
    const double s = x * (1.0 + x2 * (-1.0 / 6 + x2 * (1.0 / 120 + x2 * (-1.0 / 5040 + x2 * (1.0 / 362880 + x2 * (-1.0 / 39916800 + x2 * (1.0 / 6227020800.0)))))));
    const double c = 1.0 + x2 * (-0.5 + x2 * (1.0 / 24 + x2 * (-1.0 / 720 + x2 * (1.0 / 40320 + x2 * (-1.0 / 3628800 + x2 * (1.0 / 479001600.0 + x2 * (-1.0 / 87178291200.0)))))));
    const double s2 = 2 * s * c, c2 = 1 - 2 * s * s, s4 = 2 * s2 * c2, c4 = 1 - 2 * s2 * s2;
    ROPE[2 * e] = (float)c4; ROPE[2 * e + 1] = (float)s4;
}
__device__ __forceinline__ void rms_row_to_bf16(const float* xrow, const float* w, bf16* orow, int lane) {
    const GAS f32x4* xr = (const GAS f32x4*)xrow + lane; const GAS f32x4* wr = (const GAS f32x4*)w + lane;
    f32x4 v[4]; float s = 0.f;
#pragma unroll
    for (int j = 0; j < 4; ++j) { v[j] = xr[64 * j]; s += (v[j].x * v[j].x + v[j].y * v[j].y) + (v[j].z * v[j].z + v[j].w * v[j].w); }
    const float rinv = 1.f / sqrtf(wave_sum(s) * (1.f / DM) + EPS);
    GAS unsigned long long* o8 = (GAS unsigned long long*)orow + lane;
#pragma unroll
    for (int j = 0; j < 4; ++j) { const f32x4 ww = wr[64 * j];
        o8[64 * j] = (unsigned long long)pk2(v[j].x * rinv * ww.x, v[j].y * rinv * ww.y) | ((unsigned long long)pk2(v[j].z * rinv * ww.z, v[j].w * rinv * ww.w) << 32); }
}
__device__ __forceinline__ void p0_prologue(Frame& F, const Args& A) {
    LAS float* scr = (LAS float*)(F.lds + RING_OFF + F.wave * 16384);
    const int gw = F.vcu * NWAVES + F.wave, NGW = F.G * NWAVES;
    constexpr int I_IN = 16 * 89, I_OUT = 16 * 32, I_UP = 16 * 176, I_DN = 44 * 32, NITEMS = I_IN + I_OUT + I_UP + I_DN;
    for (int it = gw; it < NITEMS; it += NGW) {
        int r = it;
        if (r < I_IN) { const int kb = r / 89, d0 = 32 * (r % 89);
            const int sc = d0 < 2048 ? d0 : d0 < 2560 ? 2080 + (d0 - 2048) : d0 < 2816 ? 2592 + (d0 - 2560) : 2048 + (d0 - 2816);
            transpose_item(P_w_in + sc, INC, nullptr, P_WIN + (size_t)d0 * DM, DM, 64 * kb, scr, F.lane); continue; } r -= I_IN;
        if (r < I_OUT) { const int kb = r / 32, d0 = 32 * (r % 32); transpose_item(P_w_out + d0, DM, nullptr, P_WOUT + (size_t)d0 * DM, DM, 64 * kb, scr, F.lane); continue; } r -= I_OUT;
        if (r < I_UP) { const int kb = r / 176, nb = r % 176, tile = nb >> 3, wi = nb & 7; const int sc = wi < 4 ? 128 * tile + 32 * wi : FF + 128 * tile + 32 * (wi - 4);
            transpose_item(P_w_up + sc, FF2, P_norm2_w, P_WUP + (size_t)(32 * nb) * DM, DM, 64 * kb, scr, F.lane); continue; } r -= I_UP;
        { const int kb = r / 32, d0 = 32 * (r % 32); transpose_item(P_w_down + d0, DM, nullptr, P_WDN + (size_t)d0 * FF, FF, 64 * kb, scr, F.lane); }
    }
    const int gt = gw * 64 + F.lane, NTH = NGW * 64;
    for (int i = gt; i < (INP - INC) * DM / 8; i += NTH) ((GAS v4u*)(P_WIN + (size_t)INC * DM))[i] = (v4u){0u, 0u, 0u, 0u};
    for (int e = gt; e < 320 * 16; e += NTH) rope_entry(P_ROPE, e);
    for (int m = gw; m < M; m += NGW) rms_row_to_bf16(m < T0 ? P_xp + (size_t)m * DM : P_xs + (size_t)(m - T0) * DM, P_norm1_w, P_XN + (size_t)m * DM, F.lane);
}
__device__ __forceinline__ void rope8(v4u& w, const float* nw, const float* cs, const float* sn, bool second, float outscale) {
    float x[8] = {bflo(w.x), bfhi(w.x), bflo(w.y), bfhi(w.y), bflo(w.z), bfhi(w.z), bflo(w.w), bfhi(w.w)};
    float ss = 0.f;
#pragma unroll
    for (int j = 0; j < 8; ++j) ss += x[j] * x[j];
    ss += __shfl_xor(ss, 1); ss += __shfl_xor(ss, 2); ss += __shfl_xor(ss, 4);
    const float rinv = 1.f / sqrtf(ss * (1.f / 64.f) + EPS);
    float o[8];
#pragma unroll
    for (int j = 0; j < 8; ++j) { const float y = x[j] * rinv * nw[j]; const float p = __shfl_xor(y, 2); o[j] = (second ? y * cs[j] + p * sn[j] : y * cs[j] - p * sn[j]) * outscale; }
    w.x = pk2(o[0], o[1]); w.y = pk2(o[2], o[3]); w.z = pk2(o[4], o[5]); w.w = pk2(o[6], o[7]);
}
__device__ __forceinline__ void p2_rope(Frame& F, const Args& A) {
    const int gw = F.vcu * NWAVES + F.wave, NGW = F.G * NWAVES, lane = F.lane;
    const int sub = lane & 7; const bool second = (sub & 2) != 0, colpart = sub >= 4; const int i0 = 8 * (sub & 1);
    float qw[8], kw[8];
#pragma unroll
    for (int j = 0; j < 8; ++j) { qw[j] = P_q_norm_w[8 * sub + j]; kw[j] = P_k_norm_w[8 * sub + j]; }
    for (int m = gw; m < M; m += NGW) {
        const int t = m < T0 ? m : ((m - T0) & (T1 - 1));
        const int tidx = colpart ? 256 + (t & 63) : (t >> 6);
        const GAS f32x4* tab = (const GAS f32x4*)(P_ROPE + (size_t)(tidx * 16 + i0) * 2);
        float cs[8], sn[8];
#pragma unroll
        for (int j = 0; j < 4; ++j) { const f32x4 v = tab[j]; cs[2 * j] = v.x; sn[2 * j] = v.y; cs[2 * j + 1] = v.z; sn[2 * j + 1] = v.w; }
        { GAS v4u* p = (GAS v4u*)(P_MIX + (size_t)m * DM + 512) + lane; v4u w = *p; rope8(w, qw, cs, sn, second, C2Q); *p = w; }
        if (lane < 16) { GAS v4u* p = (GAS v4u*)(P_KV + (size_t)m * 256) + lane; v4u w = *p; rope8(w, kw, cs, sn, second, 1.0f); *p = w; }
    }
}
__device__ __forceinline__ void p3_mlstm_naive(Frame& F, const Args& A) {
    LAS float* red = (LAS float*)(F.lds);
    LAS float* dred = red + 1024;
    const int tid = F.tid, dv = tid & 63, dkg = F.wave;
    for (int item = blockIdx.x; item < 17 * 8; item += F.G) {
        const int seq = item >> 3, h = item & 7;
        const int T = seq == 0 ? T0 : T1; const long rowbase = seq == 0 ? 0 : T0 + (long)(seq - 1) * T1;
        const float mhw = P_mh_norm_w[h * 64 + dv];
        for (int dir = 0; dir < 2; ++dir) {
            float C[8], nn[8]; float m = 0.f;
#pragma unroll
            for (int i = 0; i < 8; ++i) { C[i] = 0.f; nn[i] = 0.f; }
            const int gi = dir * 8 + h, gf = 16 + dir * 8 + h;
            long row = rowbase + (dir ? T - 1 : 0);
            v4u kw = *(const GAS v4u*)(P_MK + row * 512 + h * 64 + dkg * 8), qw = *(const GAS v4u*)(P_MIX + row * DM + h * 64 + dkg * 8);
            unsigned short vv = P_MV[row * 512 + h * 64 + dv]; float ig = P_GT[row * 32 + gi], fg = P_GT[row * 32 + gf];
            for (int step = 0; step < T; ++step) {
                const long rowc = row; const v4u kc = kw, qc = qw; const float vc = bf2f(vv), igc = ig, fgc = fg;
                if (step + 1 < T) { row = rowbase + (dir ? T - 2 - step : step + 1);
                    kw = *(const GAS v4u*)(P_MK + row * 512 + h * 64 + dkg * 8); qw = *(const GAS v4u*)(P_MIX + row * DM + h * 64 + dkg * 8);
                    vv = P_MV[row * 512 + h * 64 + dv]; ig = P_GT[row * 32 + gi]; fg = P_GT[row * 32 + gf]; }
                const float logf = fgc < 0.f ? fgc - log1pf(expf(fgc)) : -log1pf(expf(-fgc));
                const float m_new = fmaxf(logf + m, igc), a = expf(logf + m - m_new), b = expf(igc - m_new); m = m_new;
                const float k[8] = {bflo(kc.x), bfhi(kc.x), bflo(kc.y), bfhi(kc.y), bflo(kc.z), bfhi(kc.z), bflo(kc.w), bfhi(kc.w)};
                const float q[8] = {bflo(qc.x), bfhi(qc.x), bflo(qc.y), bfhi(qc.y), bflo(qc.z), bfhi(qc.z), bflo(qc.w), bfhi(qc.w)};
                float pn = 0.f, pd = 0.f;
#pragma unroll
                for (int i = 0; i < 8; ++i) { const float bk = b * k[i]; C[i] = a * C[i] + bk * vc; nn[i] = a * nn[i] + bk; pn += q[i] * C[i]; pd += q[i] * nn[i]; }
                const int buf = step & 1; red[buf * 512 + dkg * 64 + dv] = pn; if (dv == 0) dred[buf * 8 + dkg] = pd;
                __syncthreads();
                if (tid < 64) {
                    float num = 0.f, den = 0.f;
#pragma unroll
                    for (int g = 0; g < 8; ++g) { num += red[buf * 512 + g * 64 + dv]; den += dred[buf * 8 + g]; }
                    const float hval = num / fmaxf(fabsf(den), expf(-m));
                    if (dir == 0) P_HF[rowc * 512 + h * 64 + dv] = hval;
                    else { const float hs = hval + P_HF[rowc * 512 + h * 64 + dv]; const float ss = wave_sum(hs * hs);
                        const float y = hs / sqrtf(ss * (1.f / 64.f) + EPS) * mhw; const float mo = bf2f(P_MO[rowc * 512 + h * 64 + dv]);
                        P_MIX[rowc * DM + h * 64 + dv] = (bf16)f2bf(y / (1.f + expf(-mo))); }
                }
            }
            __syncthreads();
        }
    }
}
__device__ __forceinline__ void unpack8(const v4u w, float* x) { x[0] = bflo(w.x); x[1] = bfhi(w.x); x[2] = bflo(w.y); x[3] = bfhi(w.y); x[4] = bflo(w.z); x[5] = bfhi(w.z); x[6] = bflo(w.w); x[7] = bfhi(w.w); }
__device__ __forceinline__ void conv_chunk(Frame& F, const Args& A, int c) {
    const int gt = (F.vcu * NWAVES + F.wave) * 64 + F.lane, NTH = F.G * NWAVES * 64;
    const int Tseq = c == 0 ? T0 : T1;
    const v4u Z = (v4u){0u, 0u, 0u, 0u};
    for (int ti = gt; ti < 256 * 352; ti += NTH) {
        const int cg = ti % 352, seg = ti / 352, j0 = 8 * cg, tile = j0 >> 7, jj = j0 & 127;
        const int ca = tile * 256 + jj;
        float wa[3][8], wg[3][8], ba[8], bg[8];
#pragma unroll
        for (int j = 0; j < 8; ++j) {
#pragma unroll
            for (int tp = 0; tp < 3; ++tp) { wa[tp][j] = P_conv_w[tp * FF2 + j0 + j]; wg[tp][j] = P_conv_w[tp * FF2 + FF + j0 + j]; }
            ba[j] = P_conv_b[j0 + j]; bg[j] = P_conv_b[FF + j0 + j]; }
        const int r0 = seg * 64, p0 = r0 & (Tseq - 1);
        const bf16* Ua = P_U + (size_t)r0 * FF2 + ca; const bf16* Ug = Ua + 128;
        v4u pa = Z, pg = Z;
        if (p0 > 0) { pa = *(const GAS v4u*)(Ua - FF2); pg = *(const GAS v4u*)(Ug - FF2); }
        v4u cua = *(const GAS v4u*)Ua, cug = *(const GAS v4u*)Ug;
        for (int i = 0; i < 64; ++i) {
            v4u na = Z, ng = Z;
            if (i < 63 || p0 + 64 < Tseq) { na = *(const GAS v4u*)(Ua + (size_t)(i + 1) * FF2); ng = *(const GAS v4u*)(Ug + (size_t)(i + 1) * FF2); }
            float xp[8], xc[8], xn[8], yp[8], yc[8], yn[8], o[8];
            unpack8(pa, xp); unpack8(cua, xc); unpack8(na, xn); unpack8(pg, yp); unpack8(cug, yc); unpack8(ng, yn);
#pragma unroll
            for (int j = 0; j < 8; ++j) { const float a = wa[0][j] * xp[j] + wa[1][j] * xc[j] + wa[2][j] * xn[j] + ba[j];
                const float g = wg[0][j] * yp[j] + wg[1][j] * yc[j] + wg[2][j] * yn[j] + bg[j]; o[j] = a * g / (1.f + expf(-g)); }
            v4u w; w.x = pk2(o[0], o[1]); w.y = pk2(o[2], o[3]); w.z = pk2(o[4], o[5]); w.w = pk2(o[6], o[7]);
            *(GAS v4u*)(P_ACT + (size_t)(r0 + i) * FF + j0) = w;
            pa = cua; pg = cug; cua = na; cug = ng;
        }
    }
}
__device__ __forceinline__ void p4_attn_naive(Frame& F, const Args& A) {
    LAS bf16* Ks = (LAS bf16*)F.lds; LAS bf16* Vs = Ks + 4096; LAS float* red = (LAS float*)(F.lds + 16384);
    const int tid = F.tid, qi = tid & 63, part = F.wave;
    for (int item = blockIdx.x; item < (M / 64) * 8; item += F.G) {
        const int h = item & 7, rb = item >> 3; const long row0 = (long)rb * 64;
        const long seqbase = row0 < T0 ? 0 : T0 + ((row0 - T0) / T1) * T1; const int NT = row0 < T0 ? T0 / 64 : T1 / 64;
        float q[64], o[64]; float l = 0.f;
        { const GAS v4u* qp = (const GAS v4u*)(P_MIX + (row0 + qi) * DM + 512 + h * 64);
#pragma unroll
          for (int c = 0; c < 8; ++c) { float t[8]; unpack8(qp[c], t);
#pragma unroll
              for (int j = 0; j < 8; ++j) { q[8 * c + j] = t[j]; o[8 * c + j] = 0.f; } } }
        const int kvh = h >> 2;
        for (int kt = 0; kt < NT; ++kt) {
            __syncthreads();
            { const long kr = seqbase + (long)kt * 64 + (tid >> 3); const int ch = tid & 7;
              *(LAS v4u*)(Ks + (tid >> 3) * 64 + ch * 8) = *(const GAS v4u*)(P_KV + kr * 256 + kvh * 64 + ch * 8);
              *(LAS v4u*)(Vs + (tid >> 3) * 64 + ch * 8) = *(const GAS v4u*)(P_KV + kr * 256 + 128 + kvh * 64 + ch * 8); }
            __syncthreads();
            for (int kk = 0; kk < 8; ++kk) { const int key = part * 8 + kk; float s = 0.f;
#pragma unroll
                for (int c = 0; c < 8; ++c) { float t[8]; unpack8(*(const LAS v4u*)(Ks + key * 64 + c * 8), t);
#pragma unroll
                    for (int j = 0; j < 8; ++j) s += q[8 * c + j] * t[j]; }
                const float pw = exp2f(s); l += pw;
#pragma unroll
                for (int c = 0; c < 8; ++c) { float t[8]; unpack8(*(const LAS v4u*)(Vs + key * 64 + c * 8), t);
#pragma unroll
                    for (int j = 0; j < 8; ++j) o[8 * c + j] += pw * t[j]; } }
        }
        for (int pp = 1; pp < 8; ++pp) {
            __syncthreads();
            if (part == pp) {
#pragma unroll
                for (int d = 0; d < 64; ++d) red[qi * 66 + d] = o[d];
                red[qi * 66 + 64] = l; }
            __syncthreads();
            if (part == 0) {
#pragma unroll
                for (int d = 0; d < 64; ++d) o[d] += red[qi * 66 + d];
                l += red[qi * 66 + 64]; }
        }
        if (part == 0) { const float rl = 1.f / l; GAS v4u* op = (GAS v4u*)(P_MIX + (row0 + qi) * DM + 512 + h * 64);
#pragma unroll
            for (int c = 0; c < 8; ++c) { v4u w; w.x = pk2(o[8 * c] * rl, o[8 * c + 1] * rl); w.y = pk2(o[8 * c + 2] * rl, o[8 * c + 3] * rl); w.z = pk2(o[8 * c + 4] * rl, o[8 * c + 5] * rl); w.w = pk2(o[8 * c + 6] * rl, o[8 * c + 7] * rl); op[c] = w; } }
        __syncthreads();
    }
}
__device__ __forceinline__ void final_norm(Frame& F, const Args& A) {
    const int gw = F.vcu * NWAVES + F.wave, NGW = F.G * NWAVES, lane = F.lane;
    for (int m = gw; m < M; m += NGW) {
        const float ss = wave_sum(lane < 16 ? P_PART2[(size_t)m * 16 + lane] : 0.f);
        const float rinv = 1.f / sqrtf(ss * (1.f / DM) + EPS);
        GAS f32x4* row = (GAS f32x4*)(P_out + (size_t)m * DM) + lane; const GAS f32x4* wr = (const GAS f32x4*)P_final_norm_w + lane;
#pragma unroll
        for (int j = 0; j < 4; ++j) { const f32x4 v = row[64 * j], w = wr[64 * j]; row[64 * j] = v * rinv * w; }
    }
}

#ifndef MK_FUSED
#define MK_FUSED 0
#endif
constexpr int NPH = MK_FUSED ? 16 : 10;
__global__ void __launch_bounds__(NWAVES * 64, 2) enc_fwd(Args args) {
    extern __shared__ __attribute__((aligned(16))) unsigned char lds[];
    Frame F;
    F.lds = (LAS unsigned char*)lds;
    F.MISC = (volatile LAS unsigned*)(F.lds + MISC_OFF);
    F.tid = threadIdx.x; F.lane = F.tid & 63; F.wave = __builtin_amdgcn_readfirstlane(F.tid >> 6);
    F.G = gridDim.x; { const int bx = blockIdx.x; F.vcu = (F.G % 8 == 0) ? (bx % 8) * (F.G / 8) + bx / 8 : bx; }
    const Args& A = args;
    F.ctl = (gu32*)(args.ws + WS_CTL);
    for (int u = F.tid; u < (LDS_BYTES - LDSCTL_OFF) / 4; u += NWAVES * 64) ((LAS unsigned*)(F.lds + LDSCTL_OFF))[u] = 0u;
    __syncthreads();
    const int lo = args.ph_lo, hi = args.ph_hi;
    XcdBarrier bar; bar.bar = (unsigned*)(F.ctl + CW_BAR); bar.x = 0; bar.st = nullptr;
    if (hi - lo > 1) bar = xcd_barrier_post((unsigned*)(F.ctl + CW_BAR), F.MISC + 8);
#ifndef PHMASK
#define PHMASK 0xffff
#endif
#define IN(k) (((PHMASK >> (k)) & 1) && lo <= (k) && (k) < hi)
#define SEAM(k) do { if (IN(k) && IN((k) + 1)) xcd_barrier(bar); } while (0)

    if (IN(0)) { p0_prologue(F, A); SEAM(0); }
    if (IN(1)) {
        pg8::Gemm g{P_XN, P_WIN, M, INP, DM}; pg8::StaticOrder S; S.init(M, INP, F.G, (int)blockIdx.x);
        pg8::EpiIn E{P_MIX, P_MK, P_MV, P_MO, P_KV, P_GT, P_b_gates};
        pg8::gemm_phase<pg8::EpiIn, pg8::StaticOrder, true, true>(F.lds + RING_OFF, g, S, E);
        SEAM(1);
    }
    if (IN(2)) { p2_rope(F, A); SEAM(2); }
    if (IN(3)) { p3_mlstm_naive(F, A); SEAM(3); }
#ifndef ATTN_NAIVE
#define ATTN_NAIVE 0
#endif
    if (IN(4) && ATTN_NAIVE) { p4_attn_naive(F, A); SEAM(4); }
    if (IN(4) && !ATTN_NAIVE) {
        const attn_body::UnitOrder S((int)F.G, F.vcu);
        attn_body::attn_phase<8>((char*)lds + RING_OFF, (const attn_body::bf16*)P_MIX, (const attn_body::bf16*)P_KV, (attn_body::bf16*)P_MIX, S);
        SEAM(4);
    }
    if (IN(5)) {
        pg8::Gemm g{P_MIX, P_WOUT, M, DM, DM}; pg8::StaticOrder S; S.init(M, DM, F.G, (int)blockIdx.x);
        pg8::EpiRes<true> E{P_xp, P_xs, P_out, P_XN, P_PART1, 0};
        pg8::gemm_phase<pg8::EpiRes<true>, pg8::StaticOrder, true, true>(F.lds + RING_OFF, g, S, E);
        SEAM(5);
    }
#if MK_FUSED
#define FFN_CHUNK(c, base) do { const int row_off = (c) * 16384; \
        if (IN(base)) { pg8::Gemm g{P_XN + (size_t)row_off * DM, P_WUP, 16384, FF2, DM}; pg8::StaticOrder S; S.init(16384, FF2, F.G, (int)blockIdx.x); \
            pg8::EpiUp E{P_U, P_PART1, row_off, FF2}; pg8::gemm_phase<pg8::EpiUp, pg8::StaticOrder, true, true>(F.lds + RING_OFF, g, S, E); SEAM(base); } \
        if (IN((base) + 1)) { conv_chunk(F, A, (c)); SEAM((base) + 1); } \
        if (IN((base) + 2)) { pg8::Gemm g{P_ACT, P_WDN, 16384, DM, FF}; pg8::StaticOrder S; S.init(16384, DM, F.G, (int)blockIdx.x); \
            pg8::EpiRes<false> E{P_out, P_out + (size_t)T0 * DM, P_out, nullptr, P_PART2, row_off}; pg8::gemm_phase<pg8::EpiRes<false>, pg8::StaticOrder, true, true>(F.lds + RING_OFF, g, S, E); SEAM((base) + 2); } } while (0)
    FFN_CHUNK(0, 6); FFN_CHUNK(1, 9); FFN_CHUNK(2, 12);
    if (IN(15)) final_norm(F, A);
#else
    {
        const int c = A.chunk, row_off = c * 16384;
        if (IN(6)) {
            pg8::Gemm g{P_XN + (size_t)row_off * DM, P_WUP, 16384, FF2, DM}; pg8::StaticOrder S; S.init(16384, FF2, F.G, (int)blockIdx.x);
            pg8::EpiUp E{P_U, P_PART1, row_off, FF2};
            pg8::gemm_phase<pg8::EpiUp, pg8::StaticOrder, true, true>(F.lds + RING_OFF, g, S, E);
        }
        if (IN(7)) { conv_chunk(F, A, c); }
        if (IN(8)) {
            pg8::Gemm g{P_ACT, P_WDN, 16384, DM, FF}; pg8::StaticOrder S; S.init(16384, DM, F.G, (int)blockIdx.x);
            pg8::EpiRes<false> E{P_out, P_out + (size_t)T0 * DM, P_out, nullptr, P_PART2, row_off};
            pg8::gemm_phase<pg8::EpiRes<false>, pg8::StaticOrder, true, true>(F.lds + RING_OFF, g, S, E);
        }
    }
    if (IN(9)) final_norm(F, A);
#endif
#undef IN
#undef SEAM
}

extern "C" void kernel_launch(void* const* d_in, const int* in_sizes, int n_in, void* d_out, int out_size, void* d_ws, size_t ws_size, hipStream_t stream) {
    static int grid = 0;
    if (grid == 0) {
        if (n_in != 15 || in_sizes[0] != T0 * DM || in_sizes[1] != NSEQ1 * T1 * DM || out_size != M * DM || ws_size < WS_END) {
            fprintf(stderr, "kernel_launch: unexpected shapes (n_in %d, in0 %d, out %d, ws %zu); nothing launched\n", n_in, n_in > 0 ? in_sizes[0] : -1, out_size, ws_size); grid = -1; return; }
        int dev = 0, cus = 0, per_cu = 0;
        if (hipGetDevice(&dev) != hipSuccess || hipDeviceGetAttribute(&cus, hipDeviceAttributeMultiprocessorCount, dev) != hipSuccess) { grid = -1; return; }
        if (hipFuncSetAttribute((const void*)enc_fwd, hipFuncAttributeMaxDynamicSharedMemorySize, LDS_BYTES) != hipSuccess) { fprintf(stderr, "kernel_launch: hipFuncSetAttribute failed\n"); grid = -1; return; }
        if (hipOccupancyMaxActiveBlocksPerMultiprocessor(&per_cu, (const void*)enc_fwd, NWAVES * 64, LDS_BYTES) != hipSuccess || per_cu < 1)
            fprintf(stderr, "kernel_launch: note: occupancy query reports %d workgroups per CU\n", per_cu);
        (void)hipGetLastError();
        grid = cus;
    }
    if (grid < 0) return;
    if (hipMemsetAsync((char*)d_ws + WS_CTL, 0, CTL_ZERO_BYTES, stream) != hipSuccess) { fprintf(stderr, "kernel_launch: hipMemsetAsync failed\n"); return; }
    Args a{};
    for (int i = 0; i < 15; ++i) a.in[i] = (const float*)d_in[i];
    a.out = (float*)d_out; a.ws = (unsigned char*)d_ws;
#if MK_FUSED
    a.ph_lo = 0; a.ph_hi = NPH;
    hipLaunchKernelGGL(enc_fwd, dim3(grid), dim3(NWAVES * 64), LDS_BYTES, stream, a);
#else
    for (int ph = 0; ph < 6; ++ph) { a.ph_lo = ph; a.ph_hi = ph + 1; hipLaunchKernelGGL(enc_fwd, dim3(grid), dim3(NWAVES * 64), LDS_BYTES, stream, a); }
    for (int c = 0; c < 3; ++c) for (int ph = 6; ph < 9; ++ph) { a.ph_lo = ph; a.ph_hi = ph + 1; a.chunk = c; hipLaunchKernelGGL(enc_fwd, dim3(grid), dim3(NWAVES * 64), LDS_BYTES, stream, a); }
    a.ph_lo = 9; a.ph_hi = 10; a.chunk = 0; hipLaunchKernelGGL(enc_fwd, dim3(grid), dim3(NWAVES * 64), LDS_BYTES, stream, a);
#endif
    const hipError_t le = hipPeekAtLastError();
    if (le != hipSuccess) fprintf(stderr, "kernel_launch: launch failed: %s\n", hipGetErrorName(le));
}
```

```cpp
#define MK_FUSED 1
#include <hip/hip_runtime.h>
#include <hip/hip_bf16.h>
#include <cstdio>
#include <cstdint>
#include <cmath>
namespace pg8 {
#define PG8_LAS __attribute__((address_space(3)))
typedef unsigned short bf16_t;
typedef short bf16x8 __attribute__((ext_vector_type(8)));
typedef float f32x4 __attribute__((ext_vector_type(4)));
typedef unsigned u32x4 __attribute__((ext_vector_type(4)));
constexpr int BM = 256, BK = 64, HALF = 128, HTB = HALF * BK * 2  , STAGE_BYTES = 8 * HTB, NXCD = 8, WGM = 8;

__host__ __device__ __forceinline__ int lds_byte(int r, int c) { const int st = (r >> 4) * 2 + (c >> 5), rr = r & 15, cc = c & 31, ob = rr * 64 + cc * 2; return st * 1024 + (ob ^ (((ob >> 9) & 1) << 5)); }
__host__ __device__ __forceinline__ void stage_rc(int b, int& R, int& C) { const int st = b / 1024, sb = b % 1024, swz = sb ^ (((sb >> 9) & 1) << 5); R = (st >> 1) * 16 + swz / 64; C = (st & 1) * 32 + (swz % 64) / 2; }
__host__ __device__ __forceinline__ int perm32(int rho) { const int n = rho >> 4, i = rho & 15; return 8 * (i >> 2) + 4 * n + (i & 3); }

struct Unit { int pm, pn; };
struct Gemm { const bf16_t* A; const bf16_t* Bt; int M, N, K; };

struct StaticOrder {
    int nM, nN, nwg, G, c;
    __host__ __device__ void init(int M, int N, int G_, int c_) { nM = M / BM; nN = N / BM; nwg = nM * nN; G = G_; c = c_; }
    __host__ __device__ bool next(int i, Unit& u) const {
        const long L = (long)i * G + c; if (L >= nwg) return false;
        int wgid = (int)L; { const int q = nwg / NXCD, r = nwg % NXCD, xcd = wgid % NXCD, off = wgid / NXCD; wgid = (xcd < r ? xcd * (q + 1) : r * (q + 1) + (xcd - r) * q) + off; }
        const int nig = WGM * nN, gid = wgid / nig, fm = gid * WGM, gsz = (nM - fm) < WGM ? (nM - fm) : WGM;
        u.pm = fm + ((wgid % nig) % gsz); u.pn = (wgid % nig) / gsz; return true;
    }
    __device__ __forceinline__ void a_ready(const Unit&) const {}
    __device__ __forceinline__ void done(const Unit&) const {}
};

__device__ __forceinline__ unsigned cvt_pk_bf16(float lo, float hi) { unsigned r; asm volatile("v_cvt_pk_bf16_f32 %0, %1, %2" : "=v"(r) : "v"(lo), "v"(hi)); return r; }
typedef float f32x2 __attribute__((ext_vector_type(2)));
constexpr int T0_ROWS = 16384;
struct EpiIn {
    static constexpr bool PERM = true, AFTER_DRAIN = false;
    bf16_t *MIX, *MK, *MV, *MO, *KV; float* G; const float* bg;
    __device__ __forceinline__ void operator()(const f32x4 (&acc)[2][2][4][2], const Unit& u, int wr, int wc, int fr, int fq) const {
        const int row0 = u.pm * BM + wr * 64 + fr; const int pn = u.pn;
        if (pn == 11) {
            if (wc == 0) {
                const f32x4 b0 = *(const f32x4*)(bg + 8 * fq), b1 = *(const f32x4*)(bg + 8 * fq + 4);
#pragma unroll
                for (int ai = 0; ai < 2; ++ai)
#pragma unroll
                    for (int m = 0; m < 4; ++m) { float* gp = G + (size_t)(row0 + ai * HALF + m * 16) * 32 + 8 * fq;
                        *(f32x4*)gp = acc[ai][0][m][0] + b0; *(f32x4*)(gp + 4) = acc[ai][0][m][1] + b1; }
            }
            return;
        }
        bf16_t* base; int ldc; float sc = 1.f;
        if (pn < 2) { base = MIX + pn * 256; ldc = 1024; }
        else if (pn < 4) { base = MK + (pn - 2) * 256; ldc = 512; sc = 0.125f; }
        else if (pn < 6) { base = MV + (pn - 4) * 256; ldc = 512; }
        else if (pn < 8) { base = MO + (pn - 6) * 256; ldc = 512; }
        else if (pn < 10) { base = MIX + 512 + (pn - 8) * 256; ldc = 1024; }
        else { base = KV; ldc = 256; }
        const int col0 = wc * 32 + 8 * fq;
#pragma unroll
        for (int ai = 0; ai < 2; ++ai)
#pragma unroll
            for (int m = 0; m < 4; ++m) { bf16_t* rowp = base + (size_t)(row0 + ai * HALF + m * 16) * ldc + col0;
#pragma unroll
                for (int bj = 0; bj < 2; ++bj) { const f32x4 v0 = acc[ai][bj][m][0] * sc, v1 = acc[ai][bj][m][1] * sc;
                    u32x4 w; w.x = cvt_pk_bf16(v0[0], v0[1]); w.y = cvt_pk_bf16(v0[2], v0[3]); w.z = cvt_pk_bf16(v1[0], v1[1]); w.w = cvt_pk_bf16(v1[2], v1[3]);
                    *(u32x4*)(rowp + bj * HALF) = w; } }
    }
};
template <bool WRITE_B> struct EpiRes {
    static constexpr bool PERM = false, AFTER_DRAIN = false;
    const float* base0; const float* base1; float* out; bf16_t* xb; float* part; int row_off;
    __device__ __forceinline__ void operator()(const f32x4 (&acc)[2][2][4][2], const Unit& u, int wr, int wc, int fr, int fq) const {
        typedef unsigned u32x2v __attribute__((ext_vector_type(2)));
#pragma unroll
        for (int ai = 0; ai < 2; ++ai)
#pragma unroll
            for (int m = 0; m < 4; ++m) {
                const int r = row_off + u.pm * BM + ai * HALF + wr * 64 + m * 16 + fr;
                const float* brow = (r < T0_ROWS) ? base0 + (size_t)r * 1024 : base1 + (size_t)(r - T0_ROWS) * 1024;
                float ss = 0.f;
#pragma unroll
                for (int bj = 0; bj < 2; ++bj)
#pragma unroll
                    for (int n = 0; n < 2; ++n) { const int col = u.pn * BM + bj * HALF + wc * 32 + n * 16 + 4 * fq;
                        const f32x4 o = *(const f32x4*)(brow + col) + acc[ai][bj][m][n];
                        *(f32x4*)(out + (size_t)r * 1024 + col) = o; ss += (o[0] * o[0] + o[1] * o[1]) + (o[2] * o[2] + o[3] * o[3]);
                        if (WRITE_B) { u32x2v w; w.x = cvt_pk_bf16(o[0], o[1]); w.y = cvt_pk_bf16(o[2], o[3]); *(u32x2v*)(xb + (size_t)r * 1024 + col) = w; } }
                ss += __shfl_xor(ss, 16); ss += __shfl_xor(ss, 32);
                if (fq == 0) part[(size_t)r * 16 + u.pn * 4 + wc] = ss;
            }
    }
};
struct EpiUp {
    static constexpr bool PERM = true, AFTER_DRAIN = false;
    bf16_t* U; const float* part; int row_off; int ldu;
    __device__ __forceinline__ void operator()(const f32x4 (&acc)[2][2][4][2], const Unit& u, int wr, int wc, int fr, int fq) const {
        const int col0 = u.pn * BM + wc * 32 + 8 * fq;
#pragma unroll
        for (int ai = 0; ai < 2; ++ai)
#pragma unroll
            for (int m = 0; m < 4; ++m) { const int rl = u.pm * BM + ai * HALF + wr * 64 + m * 16 + fr;
                const f32x4* pp = (const f32x4*)(part + (size_t)(row_off + rl) * 16); const f32x4 a = pp[0], b = pp[1], c = pp[2], d = pp[3];
                const float ss = ((a[0] + a[1]) + (a[2] + a[3])) + ((b[0] + b[1]) + (b[2] + b[3])) + ((c[0] + c[1]) + (c[2] + c[3])) + ((d[0] + d[1]) + (d[2] + d[3]));
                const float rinv = 1.0f / sqrtf(ss * (1.0f / 1024.0f) + 1e-6f);
                bf16_t* rowp = U + (size_t)rl * ldu + col0;
#pragma unroll
                for (int bj = 0; bj < 2; ++bj) { const f32x4 v0 = acc[ai][bj][m][0] * rinv, v1 = acc[ai][bj][m][1] * rinv;
                    u32x4 w; w.x = cvt_pk_bf16(v0[0], v0[1]); w.y = cvt_pk_bf16(v0[2], v0[3]); w.z = cvt_pk_bf16(v1[0], v1[1]); w.w = cvt_pk_bf16(v1[2], v1[3]);
                    *(u32x4*)(rowp + bj * HALF) = w; } }
    }
};

template <class Epi, class Sched, bool ALIGN_EPI = false, bool SP2 = false>
__device__ __forceinline__ void gemm_phase(PG8_LAS unsigned char* lds, const Gemm g, const Sched& S, const Epi& E) {
    const int tid = threadIdx.x, wid = __builtin_amdgcn_readfirstlane(tid >> 6), lane = tid & 63, wr = wid >> 2, wc = wid & 3, fr = lane & 15, fq = lane >> 4;
    const int K = g.K, nt = K / BK;
    unsigned voffA[2], voffB[2];
#pragma unroll
    for (int i = 0; i < 2; ++i) { int R, C; stage_rc(tid * 16 + i * 8192, R, C); const int Rb = Epi::PERM ? ((R & ~31) + perm32(R & 31)) : R;
        voffA[i] = (unsigned)(R * K + C) * 2u; voffB[i] = (unsigned)(Rb * K + C) * 2u; }
    const size_t kstep = (size_t)(BK * 2);
    const size_t hstep = (size_t)HALF * K * 2;
    const size_t tstep = 2 * hstep;
    const unsigned ldsw = (unsigned)wid * 1024u;
    const int aoff = lds_byte(wr * 64 + fr, fq * 8), boff = lds_byte(wc * 32 + fr, fq * 8);
#define PG8_SA(b, h) (((b) * 2 + (h)) * HTB)
#define PG8_SB(b, h) ((4 + (b) * 2 + (h)) * HTB)
#define PG8_STAGE(bufoff, gbase, voff) do { _Pragma("unroll") for (int _i = 0; _i < 2; ++_i) \
        __builtin_amdgcn_global_load_lds((const unsigned*)((const char*)(gbase) + (voff)[_i]), (PG8_LAS unsigned*)(lds + (bufoff) + ldsw + _i * 8192), 16, 0, 0); } while (0)
#define PG8_LDA(dst, b, h) do { _Pragma("unroll") for (int m = 0; m < 4; ++m) _Pragma("unroll") for (int k = 0; k < 2; ++k) dst[m][k] = *(const PG8_LAS bf16x8*)(lds + PG8_SA(b, h) + aoff + m * 2048 + k * 1024); } while (0)
#define PG8_LDB(dst, b, h) do { _Pragma("unroll") for (int n = 0; n < 2; ++n) _Pragma("unroll") for (int k = 0; k < 2; ++k) dst[n][k] = *(const PG8_LAS bf16x8*)(lds + PG8_SB(b, h) + boff + n * 2048 + k * 1024); } while (0)
#define PG8_MMA(ai, bj, At, Bt) do { __builtin_amdgcn_s_setprio(1); _Pragma("unroll") for (int m = 0; m < 4; ++m) _Pragma("unroll") for (int n = 0; n < 2; ++n) _Pragma("unroll") for (int k = 0; k < 2; ++k) \
        acc[ai][bj][m][n] = __builtin_amdgcn_mfma_f32_16x16x32_bf16(Bt[n][k], At[m][k], acc[ai][bj][m][n], 0, 0, 0); __builtin_amdgcn_s_setprio(0); } while (0)
#define PG8_WAIT_V(n) asm volatile("s_waitcnt vmcnt(" #n ")" ::: "memory")
#define PG8_WAIT_L(n) asm volatile("s_waitcnt lgkmcnt(" #n ")" ::: "memory")
#define PG8_BAR __builtin_amdgcn_s_barrier()
#define PG8_SCHED __builtin_amdgcn_sched_barrier(0)
    Unit cur, nxt; int ui = 0;
    if (!S.next(0, cur)) return;
    f32x4 acc[2][2][4][2];
#pragma unroll
    for (int a = 0; a < 2; ++a)
#pragma unroll
        for (int b = 0; b < 2; ++b)
#pragma unroll
            for (int m = 0; m < 4; ++m)
#pragma unroll
                for (int n = 0; n < 2; ++n) acc[a][b][m][n] = (f32x4){0.f, 0.f, 0.f, 0.f};
    bf16x8 At[4][2], B0[2][2], B1[2][2];
    const char* cA = (const char*)g.A + (size_t)cur.pm * tstep; const char* cB = (const char*)g.Bt + (size_t)cur.pn * tstep;
    S.a_ready(cur);
    if constexpr (SP2) {
        PG8_STAGE(PG8_SB(0, 0), cB, voffB); PG8_STAGE(PG8_SB(0, 1), cB + hstep, voffB); PG8_STAGE(PG8_SA(0, 0), cA, voffA); PG8_STAGE(PG8_SA(0, 1), cA + hstep, voffA);
        if (wr == 1) PG8_BAR;
        PG8_WAIT_V(2); PG8_BAR;
        PG8_STAGE(PG8_SB(1, 0), cB + kstep, voffB); PG8_STAGE(PG8_SA(1, 0), cA + kstep, voffA); PG8_STAGE(PG8_SB(1, 1), cB + hstep + kstep, voffB);
        PG8_WAIT_V(6); PG8_BAR;
    } else {
        PG8_STAGE(PG8_SB(0, 0), cB, voffB); PG8_STAGE(PG8_SA(0, 0), cA, voffA); PG8_STAGE(PG8_SB(0, 1), cB + hstep, voffB); PG8_STAGE(PG8_SA(0, 1), cA + hstep, voffA);
        if (wr == 1) PG8_BAR;
        PG8_WAIT_V(4); PG8_BAR;
        PG8_STAGE(PG8_SB(1, 0), cB + kstep, voffB); PG8_STAGE(PG8_SA(1, 0), cA + kstep, voffA); PG8_STAGE(PG8_SB(1, 1), cB + hstep + kstep, voffB);
        PG8_WAIT_V(6); PG8_BAR;
    }
    for (;;) {
        const bool has_next = S.next(ui + 1, nxt);
        const char* nA = has_next ? (const char*)g.A + (size_t)nxt.pm * tstep : cA; const char* nB = has_next ? (const char*)g.Bt + (size_t)nxt.pn * tstep : cB;
        for (int t = 0; t < nt; t += 2) {
            const bool last = (t == nt - 2);
            const char* a1 = cA + (size_t)(t + 1) * kstep;
            const char* a2 = last ? nA : cA + (size_t)(t + 2) * kstep; const char* b2 = last ? nB : cB + (size_t)(t + 2) * kstep;
            const char* a3 = a2 + kstep; const char* b3 = b2 + kstep;
            if (last && has_next) S.a_ready(nxt);
            if constexpr (SP2) {
            PG8_LDB(B0, 0, 0); PG8_LDB(B1, 0, 1); PG8_SCHED; PG8_LDA(At, 0, 0); PG8_STAGE(PG8_SA(1, 1), a1 + hstep, voffA);
            PG8_WAIT_V(8); PG8_WAIT_L(0); PG8_BAR; PG8_MMA(0, 0, At, B0); PG8_MMA(0, 1, At, B1); PG8_BAR; PG8_SCHED;
            PG8_LDA(At, 0, 1); PG8_STAGE(PG8_SB(0, 0), b2, voffB); PG8_STAGE(PG8_SB(0, 1), b2 + hstep, voffB); PG8_STAGE(PG8_SA(0, 0), a2, voffA);
            PG8_WAIT_V(8); PG8_WAIT_L(0); PG8_BAR; PG8_MMA(1, 0, At, B0); PG8_MMA(1, 1, At, B1); PG8_BAR; PG8_SCHED;
            PG8_LDB(B0, 1, 0); PG8_LDB(B1, 1, 1); PG8_SCHED; PG8_LDA(At, 1, 0); PG8_STAGE(PG8_SA(0, 1), a2 + hstep, voffA);
            PG8_WAIT_V(8); PG8_WAIT_L(0); PG8_BAR; PG8_MMA(0, 0, At, B0); PG8_MMA(0, 1, At, B1); PG8_BAR; PG8_SCHED;
            PG8_LDA(At, 1, 1); PG8_STAGE(PG8_SB(1, 0), b3, voffB); PG8_STAGE(PG8_SB(1, 1), b3 + hstep, voffB); PG8_STAGE(PG8_SA(1, 0), a3, voffA);
            PG8_WAIT_V(8); PG8_WAIT_L(0); PG8_BAR; PG8_MMA(1, 0, At, B0); PG8_MMA(1, 1, At, B1); PG8_BAR; PG8_SCHED;
            } else {
            PG8_LDB(B0, 0, 0); PG8_SCHED; PG8_LDA(At, 0, 0); PG8_STAGE(PG8_SA(1, 1), a1 + hstep, voffA);
            PG8_WAIT_L(8); PG8_BAR; PG8_WAIT_L(0); PG8_MMA(0, 0, At, B0); PG8_BAR; PG8_SCHED;
            PG8_LDB(B1, 0, 1); PG8_STAGE(PG8_SB(0, 0), b2, voffB);
            PG8_BAR; PG8_WAIT_L(0); PG8_MMA(0, 1, At, B1); PG8_BAR;
            PG8_LDA(At, 0, 1); PG8_STAGE(PG8_SA(0, 0), a2, voffA);
            PG8_BAR; PG8_WAIT_L(0); PG8_MMA(1, 0, At, B0); PG8_BAR; PG8_SCHED;
            PG8_STAGE(PG8_SB(0, 1), b2 + hstep, voffB);
            PG8_WAIT_V(6); PG8_BAR; PG8_MMA(1, 1, At, B1); PG8_BAR;
            PG8_LDB(B0, 1, 0); PG8_SCHED; PG8_LDA(At, 1, 0); PG8_STAGE(PG8_SA(0, 1), a2 + hstep, voffA);
            PG8_WAIT_L(8); PG8_BAR; PG8_WAIT_L(0); PG8_MMA(0, 0, At, B0); PG8_BAR; PG8_SCHED;
            PG8_LDB(B1, 1, 1); PG8_STAGE(PG8_SB(1, 0), b3, voffB);
            PG8_BAR; PG8_WAIT_L(0); PG8_MMA(0, 1, At, B1); PG8_BAR;
            PG8_LDA(At, 1, 1); PG8_STAGE(PG8_SA(1, 0), a3, voffA);
            PG8_BAR; PG8_WAIT_L(0); PG8_MMA(1, 0, At, B0); PG8_BAR; PG8_SCHED;
            PG8_STAGE(PG8_SB(1, 1), b3 + hstep, voffB);
            PG8_WAIT_V(6); PG8_BAR; PG8_MMA(1, 1, At, B1); PG8_BAR;
            }
        }
        if constexpr (ALIGN_EPI) { if (wr == 0) PG8_BAR; }
        if constexpr (!Epi::AFTER_DRAIN) { E(acc, cur, wr, wc, fr, fq); S.done(cur); }
        if (!has_next) break;
#pragma unroll
        for (int a = 0; a < 2; ++a)
#pragma unroll
            for (int b = 0; b < 2; ++b)
#pragma unroll
                for (int m = 0; m < 4; ++m)
#pragma unroll
                    for (int n = 0; n < 2; ++n) acc[a][b][m][n] = (f32x4){0.f, 0.f, 0.f, 0.f};
        cur = nxt; cA = nA; cB = nB; ++ui;
        if constexpr (ALIGN_EPI) { if (wr == 1) PG8_BAR; }
    }
    PG8_WAIT_V(0);
    if constexpr (!ALIGN_EPI) { if (wr == 0) PG8_BAR; }
    PG8_BAR;
    if constexpr (Epi::AFTER_DRAIN) { E.fused(acc, cur, wr, wc, fr, fq, lds, wid, lane); S.done(cur); }
#undef PG8_SA
#undef PG8_SB
#undef PG8_STAGE
#undef PG8_LDA
#undef PG8_LDB
#undef PG8_MMA
#undef PG8_WAIT_V
#undef PG8_WAIT_L
#undef PG8_BAR
#undef PG8_SCHED
}
}

namespace attn_body {
using bf16=__hip_bfloat16;
using bf16x8=__attribute__((ext_vector_type(8)))short;
using s16x4=__attribute__((ext_vector_type(4)))short;
using f32x16=__attribute__((ext_vector_type(16)))float;
using u32x4=__attribute__((ext_vector_type(4)))unsigned;
constexpr int D=64,QP=1024,KVP=256;
constexpr int NW=8,QBLK=32,QB=QBLK*NW,KVBLK=64;
constexpr int ATTN_UNIT_ROWS=QB;
__device__ __forceinline__ int crow(int r,int hi){return (r&3)+8*(r>>2)+4*hi;}
#define SBAR() __builtin_amdgcn_sched_barrier(0)
__device__ __forceinline__ void cmask(f32x16&p0,f32x16&p1,int jb,int qrel,int hi){
  const float NEG=-INFINITY; int kb=64*jb+4*hi;
  #pragma unroll
  for(int r=0;r<16;++r){int kv=kb+(r&3)+8*(r>>2); if(kv>qrel)p0[r]=NEG; if(kv+32>qrel)p1[r]=NEG;}
}

constexpr int NSLOT=3, SLOTB=8192;
constexpr int LDS_K=0, LDS_V=NSLOT*SLOTB, LDS_WS=2*NSLOT*SLOTB, LDS_OST=LDS_WS+NW*64*4, LDS_BYTES=LDS_OST+NW*4096;
constexpr float C2=0.125f*1.4426950408889634f;
__device__ __forceinline__ void glds16(const void*gsrc,unsigned lds_dst){unsigned keep;
  asm volatile("s_mov_b32 %0, m0\n\ts_mov_b32 m0, %2\n\ts_nop 0\n\tglobal_load_lds_dwordx4 %1, off\n\ts_mov_b32 m0, %0":"=&s"(keep):"v"(gsrc),"s"(lds_dst):"memory");}
__device__ __forceinline__ float max3f(float a,float b,float c){float r;asm("v_max3_f32 %0, %1, %2, %3":"=v"(r):"v"(a),"v"(b),"v"(c));return r;}
__device__ __forceinline__ float max2f(float a,float b){float r;asm("v_max_f32_e32 %0, %1, %2":"=v"(r):"v"(a),"v"(b));return r;}
__device__ __forceinline__ float fadd_s(float a,float b){float r;asm("v_add_f32_e32 %0, %1, %2":"=v"(r):"v"(a),"v"(b));return r;}
__device__ __forceinline__ float fsub_s(float a,float b){float r;asm("v_sub_f32_e32 %0, %1, %2":"=v"(r):"v"(a),"v"(b));return r;}
typedef float f32x2_t __attribute__((ext_vector_type(2))); typedef __bf16 bf16x2_t __attribute__((ext_vector_type(2)));
__device__ __forceinline__ unsigned cvtpk_s(float lo,float hi){f32x2_t v={lo,hi};bf16x2_t b=__builtin_convertvector(v,bf16x2_t);return __builtin_bit_cast(unsigned,b);}
#define WAIT_BAR(N) asm volatile("s_waitcnt vmcnt(" #N ") lgkmcnt(0)\n\ts_barrier":::"memory")

__device__ __forceinline__ void qkt(f32x16&p0,f32x16&p1,const char*Kslot,const bf16x8*qr,const f32x16&negm,int r32,int hi){
  const char*kb=Kslot+hi*1024+r32*16;
  #pragma unroll
  for(int d0=0;d0<4;++d0){
    const bf16x8 b0=*reinterpret_cast<const bf16x8*>(kb+d0*2048);
    const bf16x8 b1=*reinterpret_cast<const bf16x8*>(kb+d0*2048+512);
    if(d0==0){p0=__builtin_amdgcn_mfma_f32_32x32x16_bf16(b0,qr[0],negm,0,0,0);p1=__builtin_amdgcn_mfma_f32_32x32x16_bf16(b1,qr[0],negm,0,0,0);}
    else{p0=__builtin_amdgcn_mfma_f32_32x32x16_bf16(b0,qr[d0],p0,0,0,0);p1=__builtin_amdgcn_mfma_f32_32x32x16_bf16(b1,qr[d0],p1,0,0,0);}}
}
typedef __attribute__((address_space(3))) const char* lds_cptr;
typedef short v4i16_t __attribute__((ext_vector_type(4)));
__device__ __forceinline__ void kload8(bf16x8*kf,lds_cptr kp){
  kf[0]=*(const __attribute__((address_space(3))) bf16x8*)(kp);      kf[1]=*(const __attribute__((address_space(3))) bf16x8*)(kp+512);
  kf[2]=*(const __attribute__((address_space(3))) bf16x8*)(kp+2048); kf[3]=*(const __attribute__((address_space(3))) bf16x8*)(kp+2560);
  kf[4]=*(const __attribute__((address_space(3))) bf16x8*)(kp+4096); kf[5]=*(const __attribute__((address_space(3))) bf16x8*)(kp+4608);
  kf[6]=*(const __attribute__((address_space(3))) bf16x8*)(kp+6144); kf[7]=*(const __attribute__((address_space(3))) bf16x8*)(kp+6656);
}
__device__ __forceinline__ void kload2(bf16x8*kf,lds_cptr kp,int j){ kf[2*j]=*(const __attribute__((address_space(3))) bf16x8*)(kp+j*2048); kf[2*j+1]=*(const __attribute__((address_space(3))) bf16x8*)(kp+j*2048+512); }
__device__ __forceinline__ s16x4 vtr(lds_cptr p){ return __builtin_bit_cast(s16x4,__builtin_amdgcn_ds_read_tr16_b64_v4i16((__attribute__((address_space(3))) v4i16_t*)p)); }
__device__ __forceinline__ float rowmax(const f32x16&p0,const f32x16&p1){
  float a=max3f(p0[0],p0[1],p1[0]),b=max3f(p0[2],p0[3],p1[1]);a=max3f(a,p1[2],p1[3]);
  #pragma unroll
  for(int r=4;r<16;r+=4){a=max3f(a,p0[r],p0[r+1]);b=max3f(b,p0[r+2],p0[r+3]);a=max3f(a,p1[r],p1[r+1]);b=max3f(b,p1[r+2],p1[r+3]);}
  const float m=max2f(a,b);
  auto rr=__builtin_amdgcn_permlane32_swap(__float_as_uint(m),__float_as_uint(m),false,false);
  return max2f(__uint_as_float(rr[0]),__uint_as_float(rr[1]));
}
__device__ __forceinline__ void pv(f32x16*o,int vb,bf16x8 pa0,bf16x8 pa1,bf16x8 pa2,bf16x8 pa3){
  #pragma unroll
  for(int d0=0;d0<2;++d0){s16x4 lo[4],hi[4];
    #pragma unroll
    for(int ks=0;ks<4;++ks){
      asm volatile("ds_read_b64_tr_b16 %0,%1 offset:%c2":"=&v"(lo[ks]):"v"(vb),"i"(d0*4096+ks*1024):"memory");
      asm volatile("ds_read_b64_tr_b16 %0,%1 offset:%c2":"=&v"(hi[ks]):"v"(vb),"i"(d0*4096+ks*1024+512):"memory");}
    asm volatile("s_waitcnt lgkmcnt(0)":::"memory");SBAR();
    #define PK(k) (bf16x8){lo[k][0],lo[k][1],lo[k][2],lo[k][3],hi[k][0],hi[k][1],hi[k][2],hi[k][3]}
    o[d0]=__builtin_amdgcn_mfma_f32_32x32x16_bf16(pa0,PK(0),o[d0],0,0,0);
    o[d0]=__builtin_amdgcn_mfma_f32_32x32x16_bf16(pa1,PK(1),o[d0],0,0,0);
    o[d0]=__builtin_amdgcn_mfma_f32_32x32x16_bf16(pa2,PK(2),o[d0],0,0,0);
    o[d0]=__builtin_amdgcn_mfma_f32_32x32x16_bf16(pa3,PK(3),o[d0],0,0,0);
    #undef PK
  }
}

#ifndef ATTN_STORE16
#define ATTN_STORE16(p,v) (*(u32x4*)(p)=(v))
#endif
template<int THRL> __device__ __forceinline__ void attn_unit(long rowbase,int NT,int qcol,int kcol,int vcol,int qb,const bf16*Q,const bf16*__restrict__ K,const bf16*__restrict__ V,bf16*O,char*shm){
  const int tid=threadIdx.x,lane=tid&63,r32=lane&31,hi=lane>>5; const int wid=__builtin_amdgcn_readfirstlane(tid>>6);
  const int q0=qb*QB;
  const bf16*Qw=Q+(rowbase+q0+wid*QBLK)*QP+qcol;
  const bf16*Kh=K+rowbase*KVP+kcol,*Vh=V+rowbase*KVP+vcol;
  const unsigned lds0=(unsigned)(uintptr_t)shm;
  float*wsf=(float*)(shm+LDS_WS)+wid*64;
  const bf16*ksrc=Kh+(long)lane*KVP+wid*8;
  const bf16*vsrc=Vh+(long)(16*(wid&3)+(lane>>2))*KVP+(wid>>2)*32+(lane&3)*8;
  const unsigned kdst=lds0+LDS_K+wid*1024, vdst=lds0+LDS_V+wid*1024;
  #define DMA_K(t,slot) glds16(ksrc+(long)(t)*KVBLK*KVP,(unsigned)__builtin_amdgcn_readfirstlane(kdst+(slot)))
  #define DMA_V(t,slot) glds16(vsrc+(long)(t)*KVBLK*KVP,(unsigned)__builtin_amdgcn_readfirstlane(vdst+(slot)))
  const int vb0=(int)(lds0+LDS_V)+((lane>>4)&1)*32+(lane&3)*8+(4*hi+((lane&15)>>2))*64;
  const char*Kbase=shm+LDS_K; bf16x8 kf[8];
  const lds_cptr shm3=(lds_cptr)shm; const lds_cptr kp0=shm3+LDS_K+hi*1024+r32*16; const lds_cptr vp0=shm3+LDS_V+((lane>>4)&1)*32+(lane&3)*8+(4*hi+((lane&15)>>2))*64;
  DMA_K(0,0);DMA_V(0,0);DMA_K(1,SLOTB);
  bf16x8 qr[4];
  #pragma unroll
  for(int d0=0;d0<4;++d0)qr[d0]=*reinterpret_cast<const bf16x8*>(&Qw[(long)r32*QP+d0*16+hi*8]);
  float mhat=0.f,l_reg=0.f;f32x16 o[2];o[0]=f32x16{};o[1]=f32x16{};f32x16 negm=f32x16{};asm volatile("":"+v"(negm));
  #define CMASK(P0,P1,t) do{}while(0)
  bool resc=false;
  #define START(P0,P1) do{ const float rm=rowmax(P0,P1); resc=false; \
    { const float dl=rm; mhat=fadd_s(mhat,dl); \
      _Pragma("unroll") for(int r=0;r<16;++r){P0[r]=fsub_s(P0[r],dl);P1[r]=fsub_s(P1[r],dl);} \
      _Pragma("unroll") for(int r=0;r<16;++r)negm[r]=-mhat; asm volatile("":"+v"(negm)); } \
    _Pragma("unroll") for(int r=0;r<16;++r)P0[r]=__builtin_amdgcn_exp2f(P0[r]); }while(0)
  #define RESC() do{ if(resc){ asm volatile("s_waitcnt lgkmcnt(0)":::"memory"); \
      _Pragma("unroll") for(int d_=0;d_<2;++d_) _Pragma("unroll") for(int r=0;r<16;++r)o[d_][r]*=wsf[crow(r,hi)]; } }while(0)
  f32x16 pA0,pA1,pB0,pB1;
  int sl_prev=0,sl_cur=0,sl_next=SLOTB;
  #define ROT() do{sl_prev=sl_cur;sl_cur=sl_next;sl_next=(sl_next==(NSLOT-1)*SLOTB)?0:sl_next+SLOTB;}while(0)
  DMA_K(2,2*SLOTB);
  WAIT_BAR(3);
  qkt(pA0,pA1,Kbase,qr,negm,r32,hi);asm volatile("s_nop 15\n\ts_nop 7":"+v"(pA0),"+v"(pA1));CMASK(pA0,pA1,0);
  START(pA0,pA1);
  _Pragma("unroll") for(int r=0;r<16;++r)pA1[r]=__builtin_amdgcn_exp2f(pA1[r]);
  WAIT_BAR(0);
  DMA_K(3,0);DMA_V(1,SLOTB);
  ROT();
  kload8(kf,kp0+sl_cur);
  WAIT_BAR(2);
  s16x4 vlo[8],vhi[8]; u32x4 pw0,pw1,pw2,pw3;
  #define PKW(P,B) cvtpk_s(P[B],P[B+1])
  #define PAF(k) __builtin_bit_cast(bf16x8,pw##k)
  #define VFR(i) (bf16x8){vlo[i][0],vlo[i][1],vlo[i][2],vlo[i][3],vhi[i][0],vhi[i][1],vhi[i][2],vhi[i][3]}
  #define PIN(x) asm volatile("":"+v"(x))
  #define MX3(a,b,c) __builtin_fmaxf(__builtin_fmaxf((a),(b)),(c))
  #define GAPA(MF,A0,A1,A2,A3,W0,W1,PW) do{ MF; sacc+=A0; sacc+=A1; sacc+=A2; sacc+=A3; PIN(sacc); W0; W1; PIN(PW); SBAR(); }while(0)
  #define EX(v) __builtin_amdgcn_exp2f(v)
  #define GAPB(MF,X,B) do{ MF; X[B]=EX(X[B]); X[B+1]=EX(X[B+1]); X[B+2]=EX(X[B+2]); X[B+3]=EX(X[B+3]); PIN(X); SBAR(); }while(0)
  #define VRD(i) do{ vlo[i]=vtr(vp_+(((i)>>2)*4096+((i)&3)*1024)); vhi[i]=vtr(vp_+(((i)>>2)*4096+((i)&3)*1024+512)); }while(0)
  #define KRD(G,j) do{ if(G){ kload2(kf,kp0+sl_next,j); SBAR(); } }while(0)
  #define STEP(C0,C1,P0,P1,t,GK,GV,GL) do{ SBAR(); \
    const lds_cptr vp_=vp0+sl_prev; \
    VRD(0); SBAR(); float sacc=(P0[0]+P0[1]); \
    GAPA(C0=__builtin_amdgcn_mfma_f32_32x32x16_bf16(kf[0],qr[0],negm,0,0,0), P0[2],P0[3],P0[4],P0[5],     pw0[0]=PKW(P0,0), pw0[1]=PKW(P0,2), pw0); \
    VRD(4); SBAR(); GAPA(C1=__builtin_amdgcn_mfma_f32_32x32x16_bf16(kf[1],qr[0],negm,0,0,0), P0[6],P0[7],P0[8],P0[9],     pw0[2]=PKW(P0,4), pw0[3]=PKW(P0,6), pw0); \
    VRD(1); SBAR(); GAPA(C0=__builtin_amdgcn_mfma_f32_32x32x16_bf16(kf[2],qr[1],C0,0,0,0),   P0[10],P0[11],P0[12],P0[13], pw1[0]=PKW(P0,8), pw1[1]=PKW(P0,10), pw1); \
    VRD(5); SBAR(); GAPA(C1=__builtin_amdgcn_mfma_f32_32x32x16_bf16(kf[3],qr[1],C1,0,0,0),   P0[14],P0[15],P1[0],P1[1],   pw1[2]=PKW(P0,12),pw1[3]=PKW(P0,14), pw1); \
    VRD(2); SBAR(); GAPA(C0=__builtin_amdgcn_mfma_f32_32x32x16_bf16(kf[4],qr[2],C0,0,0,0),   P1[2],P1[3],P1[4],P1[5],     pw2[0]=PKW(P1,0), pw2[1]=PKW(P1,2), pw2); \
    VRD(6); SBAR(); GAPA(C1=__builtin_amdgcn_mfma_f32_32x32x16_bf16(kf[5],qr[2],C1,0,0,0),   P1[6],P1[7],P1[8],P1[9],     pw2[2]=PKW(P1,4), pw2[3]=PKW(P1,6), pw2); \
    VRD(3); SBAR(); GAPA(C0=__builtin_amdgcn_mfma_f32_32x32x16_bf16(kf[6],qr[3],C0,0,0,0),   P1[10],P1[11],P1[12],P1[13], pw3[0]=PKW(P1,8), pw3[1]=PKW(P1,10), pw3); \
    VRD(7); SBAR(); GAPA(C1=__builtin_amdgcn_mfma_f32_32x32x16_bf16(kf[7],qr[3],C1,0,0,0),   P1[14],P1[15],0.f,0.f,       pw3[2]=PKW(P1,12),pw3[3]=PKW(P1,14), pw3); \
    l_reg+=sacc; \
    if(GK){DMA_K((t)+3,sl_cur);} if(GV){DMA_V((t)+1,sl_next);} \
    CMASK(C0,C1,t); \
    { float a=MX3(C0[0],C0[1],C1[0]),b=MX3(C0[2],C0[3],C1[1]); a=MX3(a,C1[2],C1[3]); \
      _Pragma("unroll") for(int r=4;r<16;r+=4){a=MX3(a,C0[r],C0[r+1]);b=MX3(b,C0[r+2],C0[r+3]);a=MX3(a,C1[r],C1[r+1]);b=MX3(b,C1[r+2],C1[r+3]);} \
      float rm=__builtin_fmaxf(a,b); { auto rr=__builtin_amdgcn_permlane32_swap(__float_as_uint(rm),__float_as_uint(rm),false,false); rm=__builtin_fmaxf(__uint_as_float(rr[0]),__uint_as_float(rr[1])); } \
      resc=false; \
      if(__builtin_expect(__any(rm>(float)THRL),0)){ const float dl=__builtin_fmaxf(rm,0.f); mhat+=dl; \
        _Pragma("unroll") for(int r=0;r<16;++r){C0[r]-=dl;C1[r]-=dl;} \
        _Pragma("unroll") for(int r=0;r<16;++r)negm[r]=-mhat; asm volatile("":"+v"(negm)); \
        const float f=__builtin_amdgcn_exp2f(-dl); l_reg*=f; if(hi==0)wsf[r32]=f; resc=true; } } \
    SBAR(); \
    GAPB(o[0]=__builtin_amdgcn_mfma_f32_32x32x16_bf16(PAF(0),VFR(0),o[0],0,0,0), C0,0); \
    GAPB(o[1]=__builtin_amdgcn_mfma_f32_32x32x16_bf16(PAF(0),VFR(4),o[1],0,0,0), C0,4); \
    KRD(GL,0); GAPB(o[0]=__builtin_amdgcn_mfma_f32_32x32x16_bf16(PAF(1),VFR(1),o[0],0,0,0), C0,8); \
    KRD(GL,1); GAPB(o[1]=__builtin_amdgcn_mfma_f32_32x32x16_bf16(PAF(1),VFR(5),o[1],0,0,0), C0,12); \
    KRD(GL,2); GAPB(o[0]=__builtin_amdgcn_mfma_f32_32x32x16_bf16(PAF(2),VFR(2),o[0],0,0,0), C1,0); \
    KRD(GL,3); GAPB(o[1]=__builtin_amdgcn_mfma_f32_32x32x16_bf16(PAF(2),VFR(6),o[1],0,0,0), C1,4); \
    GAPB(o[0]=__builtin_amdgcn_mfma_f32_32x32x16_bf16(PAF(3),VFR(3),o[0],0,0,0), C1,8); \
    GAPB(o[1]=__builtin_amdgcn_mfma_f32_32x32x16_bf16(PAF(3),VFR(7),o[1],0,0,0), C1,12); \
    }while(0)
  int t=1;
  #undef CMASK
  #define CMASK(P0,P1,t) do{}while(0)
  for(;t+5<NT;t+=2){
    STEP(pB0,pB1,pA0,pA1,t,true,true,true);     WAIT_BAR(2); RESC(); ROT();
    STEP(pA0,pA1,pB0,pB1,t+1,true,true,true);   WAIT_BAR(2); RESC(); ROT();
  }
  #undef CMASK
  #define CMASK(P0,P1,t) do{}while(0)
  #define ENDW(tt) do{ if((tt)+3<NT){WAIT_BAR(2);} else if((tt)+2<NT){WAIT_BAR(1);} else {WAIT_BAR(0);} }while(0)
  for(;t+1<NT;t+=2){
    STEP(pB0,pB1,pA0,pA1,t,(t+3<NT),(t+1<NT),(t+1<NT));       ENDW(t);   RESC(); ROT();
    STEP(pA0,pA1,pB0,pB1,t+1,(t+4<NT),(t+2<NT),(t+2<NT));     ENDW(t+1); RESC(); ROT();
  }
  STEP(pB0,pB1,pA0,pA1,NT-1,false,false,false); RESC();
  { float sacc=pB0[0]+pB0[1]; _Pragma("unroll") for(int r=2;r<16;++r)sacc+=pB0[r]; _Pragma("unroll") for(int r=0;r<16;++r)sacc+=pB1[r]; l_reg+=sacc;
    pw0=(u32x4){PKW(pB0,0),PKW(pB0,2),PKW(pB0,4),PKW(pB0,6)};pw1=(u32x4){PKW(pB0,8),PKW(pB0,10),PKW(pB0,12),PKW(pB0,14)};pw2=(u32x4){PKW(pB1,0),PKW(pB1,2),PKW(pB1,4),PKW(pB1,6)};pw3=(u32x4){PKW(pB1,8),PKW(pB1,10),PKW(pB1,12),PKW(pB1,14)};
    SBAR(); pv(o,vb0+sl_cur,PAF(0),PAF(1),PAF(2),PAF(3)); }
  #undef PKW
  #undef PAF
  #undef VFR
  #undef PIN
  #undef MX3
  #undef GAPA
  #undef GAPB
  #undef EX
  #undef VRD
  #undef KRD
  #undef STEP
  #undef ENDW
  {auto rr=__builtin_amdgcn_permlane32_swap(__float_as_uint(l_reg),__float_as_uint(l_reg),false,false);l_reg=__uint_as_float(rr[0])+__uint_as_float(rr[1]);}
  if(hi==0)wsf[32+r32]=l_reg;asm volatile("s_waitcnt lgkmcnt(0)":::"memory");
  float rli[16];
  #pragma unroll
  for(int r=0;r<16;++r)rli[r]=__builtin_amdgcn_rcpf(wsf[32+crow(r,hi)]);
  bf16*Ow=O+(rowbase+q0+wid*QBLK)*QP+qcol;
  { bf16*stg=(bf16*)(shm+LDS_OST)+wid*2048;
    #pragma unroll
    for(int r=0;r<16;++r){const int orow=crow(r,hi);
      #pragma unroll
      for(int d0=0;d0<2;++d0)stg[orow*64+d0*32+r32]=__float2bfloat16(o[d0][r]*rli[r]);}
    asm volatile("s_waitcnt lgkmcnt(0)":::"memory");
    #pragma unroll
    for(int i=0;i<4;++i){const int row=i*8+(lane>>3),ch=lane&7; const u32x4 v=*(const u32x4*)(stg+row*64+ch*8); ATTN_STORE16(Ow+(long)row*QP+ch*8,v);} }
  asm volatile("s_waitcnt lgkmcnt(0)\n\ts_barrier":::"memory");
  #undef DMA_K
  #undef DMA_V
  #undef CMASK
  #undef START
  #undef RESC
  #undef ROT
}
constexpr int ATTN_LDS_BYTES=LDS_BYTES;

struct AttnUnit { long rowbase; int NT, h, qb; };
struct UnitOrder {
  int vcu, G;
  __device__ __forceinline__ UnitOrder(int grid,int v):vcu(v),G(grid){}
  __device__ __forceinline__ bool next(int i,AttnUnit&u)const{
    const int v=vcu+(i/6)*G, j=i%6; if(v>=256)return false;
    if(j<2){ const int pu=2*v+j; u.rowbase=0; u.NT=256; u.h=pu>>6; u.qb=pu&63; }
    else { const int su=4*v+(j-2); u.rowbase=16384+(long)(su>>6)*2048; u.NT=32; u.h=(su>>3)&7; u.qb=su&7; }
    return true; }
};
template<int THRL=8> __device__ __forceinline__ void attn_phase(char*lds,const bf16*MIXQ,const bf16*KV,bf16*MIXO,const UnitOrder&S){
  AttnUnit u;
  for(int i=0;S.next(i,u);++i){ attn_unit<THRL>(u.rowbase,u.NT,512+u.h*64,(u.h>>2)*64,128+(u.h>>2)*64,u.qb,MIXQ,KV,KV,MIXO,lds); }
}
namespace mls {
constexpr int SC=256, ST_STRIDE=4176, NITEM=192*8;
constexpr int ML_K=0, ML_V=32768, ML_ARR=65536, ML_CF=73728, ML_CB=82944, ML_N=92160, ML_SCAL=92672, ML_WS=93184, ML_STG=95232, ML_END=128000;
constexpr int CROWB=144;
constexpr float L2E=1.4426950408889634f, MEPS=1e-6f;
typedef float f32x4m __attribute__((ext_vector_type(4)));
__device__ __forceinline__ float blo(unsigned w){return __builtin_bit_cast(float,w<<16);}
__device__ __forceinline__ float bhi(unsigned w){return __builtin_bit_cast(float,w&0xffff0000u);}
__device__ __forceinline__ float sbf(short v){return __builtin_bit_cast(float,((unsigned)(unsigned short)v)<<16);}
__device__ __forceinline__ float logsig(float x){ return x<0.f ? x-log1pf(__expf(x)) : -log1pf(__expf(-x)); }
__device__ __forceinline__ float scan_sum(float v,int lane){
  #pragma unroll
  for(int o=1;o<64;o<<=1){ const float t=__shfl_up(v,o); if(lane>=o) v+=t; } return v; }
__device__ __forceinline__ float scan_max(float v,int lane){
  #pragma unroll
  for(int o=1;o<64;o<<=1){ const float t=__shfl_up(v,o); if(lane>=o) v=fmaxf(v,t); } return v; }
__device__ __forceinline__ float rscan_max(float v,int lane){
  #pragma unroll
  for(int o=1;o<64;o<<=1){ const float t=__shfl_down(v,o); if(lane+o<64) v=fmaxf(v,t); } return v; }
__device__ __forceinline__ float wmaxf(float v){
  #pragma unroll
  for(int o=1;o<64;o<<=1) v=fmaxf(v,__shfl_xor(v,o));
  return v; }
template<int MODE> __device__ __forceinline__ void gate_setup(const float*GT,long row0,int h,const float*st,char*shm,int lane){
  float*ARR=(float*)(shm+ML_ARR); float*SCAL=(float*)(shm+ML_SCAL);
  float i_f[4],i_b[4],lf[4],lb[4];
  #pragma unroll
  for(int k=0;k<4;++k){ const float*g=GT+(row0+4*lane+k)*32; i_f[k]=g[h]; i_b[k]=g[8+h]; lf[k]=logsig(g[16+h]); lb[k]=logsig(g[24+h]); }
  float pf[4],pb[4]; pf[0]=lf[0]; pb[0]=lb[0];
  #pragma unroll
  for(int k=1;k<4;++k){ pf[k]=pf[k-1]+lf[k]; pb[k]=pb[k-1]+lb[k]; }
  const float inF=scan_sum(pf[3],lane), inB=scan_sum(pb[3],lane); const float offF=inF-pf[3], offB=inB-pb[3];
  const float totF=__shfl(inF,63), totB=__shfl(inB,63);
  float P[4],R[4];
  #pragma unroll
  for(int k=0;k<4;++k){ P[k]=offF+pf[k]; R[k]=totB-(offB+pb[k])+lb[k]; }
  if(MODE==1){
    float wF[4],wB[4]; float mxF=-INFINITY,mxB=-INFINITY;
    #pragma unroll
    for(int k=0;k<4;++k){ wF[k]=totF-P[k]+i_f[k]; wB[k]=(totB-R[k])+i_b[k]; mxF=fmaxf(mxF,wF[k]); mxB=fmaxf(mxB,wB[k]); }
    const float aF=wmaxf(mxF), aB=wmaxf(mxB);
    #pragma unroll
    for(int k=0;k<4;++k){ ARR[4*lane+k]=__expf(wF[k]-aF); ARR[256+4*lane+k]=__expf(wB[k]-aB); }
    if(lane==0){ SCAL[0]=aF; SCAL[1]=totF; SCAL[2]=aB; SCAL[3]=totB; }
  } else {
    const float mFp=st[4162], mBp=st[ST_STRIDE+4162];
    float gF[4],gB[4],pm[4],sm[4];
    #pragma unroll
    for(int k=0;k<4;++k){ gF[k]=i_f[k]-P[k]; gB[k]=i_b[k]-R[k]; }
    pm[0]=gF[0]; sm[3]=gB[3];
    #pragma unroll
    for(int k=1;k<4;++k){ pm[k]=fmaxf(pm[k-1],gF[k]); sm[3-k]=fmaxf(sm[4-k],gB[3-k]); }
    const float inc=scan_max(pm[3],lane); float exc=__shfl_up(inc,1); if(lane==0)exc=-INFINITY;
    const float incr=rscan_max(sm[0],lane); float excr=__shfl_down(incr,1); if(lane==63)excr=-INFINITY;
    #pragma unroll
    for(int k=0;k<4;++k){ const int s=4*lane+k; const float muF=fmaxf(mFp,fmaxf(exc,pm[k])), muB=fmaxf(mBp,fmaxf(excr,sm[k]));
      ARR[s]=gF[k]*L2E; ARR[256+s]=gB[k]*L2E; ARR[512+s]=muF*L2E; ARR[768+s]=muB*L2E; ARR[1024+s]=__expf(mFp-muF); ARR[1280+s]=__expf(mBp-muB);
      ARR[1536+s]=__expf(-(P[k]+muF)); ARR[1792+s]=__expf(-(R[k]+muB)); }
  }
}
__device__ __forceinline__ void load_kv(const bf16*Kh,const bf16*Vh,unsigned lds0,int wid,int lane){
  #pragma unroll
  for(int t=0;t<4;++t){
    glds16(Kh+(long)(t*64+lane)*512+wid*8,(unsigned)__builtin_amdgcn_readfirstlane(lds0+ML_K+t*8192+wid*1024));
    glds16(Vh+(long)(t*64+16*(wid&3)+(lane>>2))*512+(wid>>2)*32+(lane&3)*8,(unsigned)__builtin_amdgcn_readfirstlane(lds0+ML_V+t*8192+wid*1024)); }
}
__device__ __forceinline__ void m1_item(int item,const bf16*MK,const bf16*MV,const float*GT,float*STATE,char*shm){
  const int tid=threadIdx.x,lane=tid&63,r32=lane&31,hi=lane>>5; const int wid=__builtin_amdgcn_readfirstlane(tid>>6);
  const int scg=item>>3,h=item&7; const long row0=(long)scg*SC;
  const unsigned lds0=(unsigned)(uintptr_t)shm;
  load_kv(MK+row0*512+h*64,MV+row0*512+h*64,lds0,wid,lane);
  float*st=STATE+(size_t)item*2*ST_STRIDE;
  if(wid==0) gate_setup<1>(GT,row0,h,st,shm,lane);
  asm volatile("s_waitcnt vmcnt(0) lgkmcnt(0)":::"memory"); __syncthreads();
  const float*ARR=(const float*)(shm+ML_ARR);
  const int dir=wid>>2, mt=(wid>>1)&1, nt=wid&1;
  const float*we=ARR+dir*256;
  f32x16 acc=f32x16{};
  const lds_cptr shm3=(lds_cptr)shm;
  const lds_cptr vp0=shm3+ML_V+mt*4096+((lane>>4)&1)*32+(lane&3)*8+(4*hi+((lane&15)>>2))*64;
  const int kcol=32*nt+16*((lane>>4)&1)+4*(lane&3);
  const lds_cptr kp0=shm3+ML_K+(kcol>>3)*1024+(4*hi+((lane&15)>>2))*16+(kcol&7)*2;
  #pragma unroll
  for(int t=0;t<4;++t){
    #pragma unroll
    for(int ks=0;ks<4;++ks){
      const s16x4 alo=vtr(vp0+t*8192+ks*1024), ahi=vtr(vp0+t*8192+ks*1024+512);
      const s16x4 klo=vtr(kp0+t*8192+ks*256), khi=vtr(kp0+t*8192+ks*256+128);
      const f32x4m w0=*(const f32x4m*)(we+64*t+16*ks+4*hi), w1=*(const f32x4m*)(we+64*t+16*ks+8+4*hi);
      u32x4 aw; aw[0]=cvtpk_s(sbf(alo[0])*w0[0],sbf(alo[1])*w0[1]); aw[1]=cvtpk_s(sbf(alo[2])*w0[2],sbf(alo[3])*w0[3]);
      aw[2]=cvtpk_s(sbf(ahi[0])*w1[0],sbf(ahi[1])*w1[1]); aw[3]=cvtpk_s(sbf(ahi[2])*w1[2],sbf(ahi[3])*w1[3]);
      const bf16x8 Bf=(bf16x8){klo[0],klo[1],klo[2],klo[3],khi[0],khi[1],khi[2],khi[3]};
      acc=__builtin_amdgcn_mfma_f32_32x32x16_bf16(__builtin_bit_cast(bf16x8,aw),Bf,acc,0,0,0); } }
  float*cst=st+(size_t)dir*ST_STRIDE;
  #pragma unroll
  for(int r=0;r<16;++r) cst[(32*mt+crow(r,hi))*64+32*nt+r32]=acc[r];
  if(tid<128){ const int d=tid>>6, dk=tid&63; const float*wv=ARR+d*256; float s=0.f;
    const unsigned short*kimg=(const unsigned short*)(shm+ML_K+(dk>>3)*1024+(dk&7)*2);
    for(int t=0;t<4;++t) for(int kl=0;kl<64;++kl) s+=wv[64*t+kl]*__builtin_bit_cast(float,((unsigned)kimg[t*4096+kl*8])<<16);
    st[(size_t)d*ST_STRIDE+4096+dk]=s; }
  if(tid==0){ const float*SCAL=(const float*)(shm+ML_SCAL); st[4160]=SCAL[0]; st[4161]=SCAL[1]; st[ST_STRIDE+4160]=SCAL[2]; st[ST_STRIDE+4161]=SCAL[3]; }
  __syncthreads();
}
__device__ __forceinline__ void m2_scan(float*STATE,int gt,int NTH){
  constexpr int NV=1040, NP=16*NV, NS=16*16*NV;
  for(int ti=gt;ti<NP+NS;ti+=NTH){
    int seq,r; if(ti<NP){seq=0;r=ti;} else { const int r2=ti-NP; seq=1+r2/NP; r=r2%NP; }
    const int hd=r/NV, e=r%NV, h=hd>>1, dir=hd&1;
    const int nsc=seq==0?64:8, sc0=seq==0?0:64+(seq-1)*8;
    f32x4m state=(f32x4m){0.f,0.f,0.f,0.f}; float m=0.f;
    for(int s0=0;s0<nsc;s0+=8){
      f32x4m loc[8]; float av[8],bl[8];
      #pragma unroll
      for(int j=0;j<8;++j){ const int step=s0+j, c=dir?nsc-1-step:step; float*base=STATE+((size_t)((sc0+c)*8+h)*2+dir)*ST_STRIDE;
        loc[j]=*(const f32x4m*)(base+4*e); av[j]=base[4160]; bl[j]=base[4161]; }
      #pragma unroll
      for(int j=0;j<8;++j){ const int step=s0+j, c=dir?nsc-1-step:step; float*base=STATE+((size_t)((sc0+c)*8+h)*2+dir)*ST_STRIDE;
        *(f32x4m*)(base+4*e)=state; if(e==0) base[4162]=m;
        const float mn=fmaxf(bl[j]+m,av[j]), dec=__expf(bl[j]+m-mn), wl=__expf(av[j]-mn);
        state=state*dec+loc[j]*wl; m=mn; }
    }
  }
}
__device__ __forceinline__ void m3_item(int item,const bf16*Q,const bf16*MK,const bf16*MV,const bf16*MO,const float*GT,const float*STATE,const float*mhw,bf16*OUT,char*shm){
  const int tid=threadIdx.x,lane=tid&63,r32=lane&31,hi=lane>>5; const int wid=__builtin_amdgcn_readfirstlane(tid>>6);
  const int scg=item>>3,h=item&7; const long row0=(long)scg*SC;
  const unsigned lds0=(unsigned)(uintptr_t)shm;
  load_kv(MK+row0*512+h*64,MV+row0*512+h*64,lds0,wid,lane);
  const float*st=STATE+(size_t)item*2*ST_STRIDE;
  { const int dv=tid>>3,c8=tid&7;
    #pragma unroll
    for(int d=0;d<2;++d){ const f32x4m a=*(const f32x4m*)(st+(size_t)d*ST_STRIDE+dv*64+c8*8), b=*(const f32x4m*)(st+(size_t)d*ST_STRIDE+dv*64+c8*8+4);
      u32x4 w; w[0]=cvtpk_s(a[0],a[1]); w[1]=cvtpk_s(a[2],a[3]); w[2]=cvtpk_s(b[0],b[1]); w[3]=cvtpk_s(b[2],b[3]);
      *(u32x4*)(shm+(d?ML_CB:ML_CF)+dv*CROWB+c8*16)=w; } }
  if(tid<128) ((float*)(shm+ML_N))[tid]=st[(size_t)(tid>>6)*ST_STRIDE+4096+(tid&63)];
  if(wid==0) gate_setup<3>(GT,row0,h,st,shm,lane);
  asm volatile("s_waitcnt vmcnt(0) lgkmcnt(0)":::"memory"); __syncthreads();
  const float*ARR=(const float*)(shm+ML_ARR);
  const int l=32*wid+r32; const long qrow=row0+l;
  bf16x8 qr[4];
  #pragma unroll
  for(int ks=0;ks<4;++ks) qr[ks]=*reinterpret_cast<const bf16x8*>(&Q[qrow*1024+h*64+ks*16+hi*8]);
  const float muF=ARR[512+l], muB=ARR[768+l], iwF=ARR[1024+l], iwB=ARR[1280+l], flF=ARR[1536+l], flB=ARR[1792+l];
  const float*nF=(const float*)(shm+ML_N); const float*nB=nF+64;
  float qnF=0.f,qnB=0.f;
  f32x16 oF[2],oB[2]; oF[0]=f32x16{}; oF[1]=f32x16{}; oB[0]=f32x16{}; oB[1]=f32x16{};
  #pragma unroll
  for(int ks=0;ks<4;++ks){ float x[8];
    #pragma unroll
    for(int j=0;j<8;++j) x[j]=sbf(qr[ks][j]);
    #pragma unroll
    for(int j=0;j<8;++j){ qnF+=x[j]*nF[16*ks+8*hi+j]; qnB+=x[j]*nB[16*ks+8*hi+j]; }
    { u32x4 wf;
      #pragma unroll
      for(int j=0;j<4;++j) wf[j]=cvtpk_s(x[2*j]*iwF,x[2*j+1]*iwF);
      #pragma unroll
      for(int nt=0;nt<2;++nt){ const bf16x8 bF=*reinterpret_cast<const bf16x8*>(shm+ML_CF+(32*nt+r32)*CROWB+(16*ks+8*hi)*2);
        oF[nt]=__builtin_amdgcn_mfma_f32_32x32x16_bf16(__builtin_bit_cast(bf16x8,wf),bF,oF[nt],0,0,0); } }
    { u32x4 wb;
      #pragma unroll
      for(int j=0;j<4;++j) wb[j]=cvtpk_s(x[2*j]*iwB,x[2*j+1]*iwB);
      #pragma unroll
      for(int nt=0;nt<2;++nt){ const bf16x8 bB=*reinterpret_cast<const bf16x8*>(shm+ML_CB+(32*nt+r32)*CROWB+(16*ks+8*hi)*2);
        oB[nt]=__builtin_amdgcn_mfma_f32_32x32x16_bf16(__builtin_bit_cast(bf16x8,wb),bB,oB[nt],0,0,0); } } }
  qnF+=__shfl_xor(qnF,32); qnB+=__shfl_xor(qnB,32);
  float denF=0.f,denB=0.f;
  const int vb0=(int)(lds0+ML_V)+((lane>>4)&1)*32+(lane&3)*8+(4*hi+((lane&15)>>2))*64;
  const char*Kbase=shm+ML_K;
  const int dt=wid>>1;
  #pragma unroll 1
  for(int kt=0;kt<4;++kt){
    f32x16 p0,p1; const f32x16 z=f32x16{};
    qkt(p0,p1,Kbase+kt*8192,qr,z,r32,hi);
    if(kt<=dt){
      const float*g=ARR+64*kt; u32x4 w0,w1,w2,w3;
      #pragma unroll
      for(int j=0;j<8;++j){ float a0[2],a1[2];
        #pragma unroll
        for(int e=0;e<2;++e){ const int r=2*j+e, k0=crow(r,hi), key0=64*kt+k0;
          a0[e]=p0[r]*__builtin_amdgcn_exp2f(fminf(g[k0]-muF,0.f)); a1[e]=p1[r]*__builtin_amdgcn_exp2f(fminf(g[k0+32]-muF,0.f));
          if(kt==dt){ if(key0>l)a0[e]=0.f; if(key0+32>l)a1[e]=0.f; }
          denF+=a0[e]+a1[e]; }
        const unsigned c0=cvtpk_s(a0[0],a0[1]), c1=cvtpk_s(a1[0],a1[1]);
        if(j<4){ w0[j]=c0; w2[j]=c1; } else { w1[j-4]=c0; w3[j-4]=c1; } }
      pv(oF,vb0+kt*8192,__builtin_bit_cast(bf16x8,w0),__builtin_bit_cast(bf16x8,w1),__builtin_bit_cast(bf16x8,w2),__builtin_bit_cast(bf16x8,w3)); }
    if(kt>=dt){
      const float*g=ARR+256+64*kt; u32x4 w0,w1,w2,w3;
      #pragma unroll
      for(int j=0;j<8;++j){ float a0[2],a1[2];
        #pragma unroll
        for(int e=0;e<2;++e){ const int r=2*j+e, k0=crow(r,hi), key0=64*kt+k0;
          a0[e]=p0[r]*__builtin_amdgcn_exp2f(fminf(g[k0]-muB,0.f)); a1[e]=p1[r]*__builtin_amdgcn_exp2f(fminf(g[k0+32]-muB,0.f));
          if(kt==dt){ if(key0<l)a0[e]=0.f; if(key0+32<l)a1[e]=0.f; }
          denB+=a0[e]+a1[e]; }
        const unsigned c0=cvtpk_s(a0[0],a0[1]), c1=cvtpk_s(a1[0],a1[1]);
        if(j<4){ w0[j]=c0; w2[j]=c1; } else { w1[j-4]=c0; w3[j-4]=c1; } }
      pv(oB,vb0+kt*8192,__builtin_bit_cast(bf16x8,w0),__builtin_bit_cast(bf16x8,w1),__builtin_bit_cast(bf16x8,w2),__builtin_bit_cast(bf16x8,w3)); }
  }
  denF+=__shfl_xor(denF,32); denB+=__shfl_xor(denB,32);
  const float rF=1.f/fmaxf(fabsf(denF+iwF*qnF),flF), rB=1.f/fmaxf(fabsf(denB+iwB*qnB),flB);
  float*wsf=(float*)(shm+ML_WS)+wid*64;
  if(hi==0){ wsf[r32]=rF; wsf[32+r32]=rB; }
  asm volatile("s_waitcnt lgkmcnt(0)":::"memory");
  const float mw0=mhw[h*64+r32], mw1=mhw[h*64+32+r32];
  bf16*stg=(bf16*)(shm+ML_STG)+wid*2048;
  #pragma unroll
  for(int r=0;r<16;++r){ const int orow=crow(r,hi); const float sF=wsf[orow], sB=wsf[32+orow];
    const float h0=oF[0][r]*sF+oB[0][r]*sB, h1=oF[1][r]*sF+oB[1][r]*sB;
    float ss=h0*h0+h1*h1;
    ss+=__shfl_xor(ss,1); ss+=__shfl_xor(ss,2); ss+=__shfl_xor(ss,4); ss+=__shfl_xor(ss,8); ss+=__shfl_xor(ss,16);
    const float rstd=1.f/sqrtf(ss*(1.f/64.f)+MEPS);
    stg[orow*64+r32]=__float2bfloat16(h0*rstd*mw0); stg[orow*64+32+r32]=__float2bfloat16(h1*rstd*mw1); }
  asm volatile("s_waitcnt lgkmcnt(0)":::"memory");
  #pragma unroll
  for(int i=0;i<4;++i){ const int row=i*8+(lane>>3),ch=lane&7; const u32x4 v=*(const u32x4*)(stg+row*64+ch*8);
    const long grow=row0+32*wid+row; const u32x4 mo=*(const u32x4*)(MO+grow*512+h*64+ch*8); u32x4 o;
    #pragma unroll
    for(int j=0;j<4;++j){ const float y0=blo(v[j])/(1.f+__expf(-blo(mo[j]))), y1=bhi(v[j])/(1.f+__expf(-bhi(mo[j]))); o[j]=cvtpk_s(y0,y1); }
    *(u32x4*)(OUT+grow*1024+h*64+ch*8)=o; }
  __syncthreads();
}
}
#undef SBAR
#undef WAIT_BAR
}


constexpr int NWAVES = 8;
constexpr int DM = 1024, T0 = 16384, NSEQ1 = 16, T1 = 2048, M = T0 + NSEQ1 * T1;
constexpr int HD = 64, NH = 8, MW = 512, INC = 2848, INP = 3072, FF = 2816, FF2 = 5632;
constexpr float EPS = 1e-6f;
static_assert(M == 49152 && M % 256 == 0 && pg8::T0_ROWS == T0, "shapes");

constexpr size_t MiB = 1u << 20;
constexpr size_t WS_CTL = 0, CTL_ZERO_BYTES = 1 * MiB;
constexpr size_t WS_WIN = 2 * MiB, WS_WOUT = 8 * MiB, WS_WUP = 10 * MiB, WS_WDN = 21 * MiB;
constexpr size_t WS_ROPE = 27 * MiB;
constexpr size_t WS_PART1 = 28 * MiB, WS_PART2 = 31 * MiB;
constexpr size_t WS_G = 34 * MiB;
constexpr size_t WS_KV = 40 * MiB;
constexpr size_t WS_XN = 64 * MiB;
constexpr size_t WS_MIX = 160 * MiB;
constexpr size_t WS_MK = 256 * MiB, WS_MV = 304 * MiB, WS_MO = 352 * MiB;
constexpr size_t WS_HF = 400 * MiB;
constexpr size_t WS_U = 160 * MiB, WS_ACT = 336 * MiB;
constexpr size_t WS_END = 496 * MiB;
constexpr int CW_BAR = 4096;

constexpr int RING_OFF = 0, RING_BYTES = 131072;
constexpr int LDSCTL_OFF = RING_BYTES, MISC_OFF = LDSCTL_OFF + 320;
constexpr int LDS_BYTES = 147456;

#define GAS __attribute__((address_space(1)))
#define LAS __attribute__((address_space(3)))
typedef unsigned short bf16;
typedef unsigned v4u __attribute__((ext_vector_type(4)));
typedef float f32x4 __attribute__((ext_vector_type(4)));
typedef GAS unsigned gu32;
#define RLX_AGENT __ATOMIC_RELAXED, __HIP_MEMORY_SCOPE_AGENT
#define LDS_WAIT() asm volatile("s_waitcnt lgkmcnt(0)" ::: "memory")
#define VM_WAIT() asm volatile("s_waitcnt vmcnt(0)" ::: "memory")
__device__ __forceinline__ unsigned f2bf(float f) { unsigned u = __builtin_bit_cast(unsigned, f); return (u + 0x7fffu + ((u >> 16) & 1u)) >> 16; }
__device__ __forceinline__ unsigned pk2(float lo, float hi) { return f2bf(lo) | (f2bf(hi) << 16); }
__device__ __forceinline__ float bf2f(unsigned short b) { return __builtin_bit_cast(float, (unsigned)b << 16); }
__device__ __forceinline__ float bflo(unsigned w) { return __builtin_bit_cast(float, w << 16); }
__device__ __forceinline__ float bfhi(unsigned w) { return __builtin_bit_cast(float, w & 0xffff0000u); }
#define XB_TMO      128
#define XB_XCNT(j)  (256  + 64 * (j))
#define XB_XSUB(j)  (1280 + 64 * (j))
#define XB_XGEN(j)  (2304 + 64 * (j))
#define XB_TOP      3328
#define XB_TOPGEN   3392
#define XCD_BAR_WORDS 3456
#define XB_SPIN_CAP (1u << 24)

__device__ __forceinline__ unsigned xb_ld(unsigned* p)              { return __hip_atomic_load(p, __ATOMIC_RELAXED, __HIP_MEMORY_SCOPE_AGENT); }
__device__ __forceinline__ unsigned xb_add(unsigned* p, unsigned v) { return __hip_atomic_fetch_add(p, v, __ATOMIC_RELAXED, __HIP_MEMORY_SCOPE_AGENT); }
__device__ __forceinline__ unsigned xb_xcc_id() { return (unsigned)__builtin_amdgcn_s_getreg((3 << 11) | 20) & 0xFu; }
#define XB_SPIN(cond, bar) do { unsigned _sp = 0; while (cond) { __builtin_amdgcn_s_sleep(1); \
    if ((++_sp & 255u) == 0u) { if (xb_ld(&(bar)[XB_TMO])) break; if (_sp > XB_SPIN_CAP) { atomicAdd(&(bar)[XB_TMO], 1u); break; } } } } while (0)

struct XcdBarrier {
    unsigned* bar; unsigned x;
    volatile LAS unsigned* st;
};

__device__ __forceinline__ XcdBarrier xcd_barrier_post(unsigned* bar, volatile LAS unsigned* st) {
    XcdBarrier b; b.bar = bar; b.x = xb_xcc_id(); b.st = st;
    if (threadIdx.x == 0) (void)xb_add(&bar[XB_XCNT(b.x)], 1u);
    return b;
}
__device__ __forceinline__ void xcd_barrier_complete(unsigned* bar, unsigned x, unsigned& nloc, unsigned& nx) {
    const unsigned G = gridDim.x * gridDim.y * gridDim.z;
    unsigned sum, cnt, mine, sp = 0u;
    for (;;) {
        sum = 0u; cnt = 0u; mine = 0u;
#pragma unroll
        for (unsigned j = 0; j < 16; ++j) { const unsigned c = xb_ld(&bar[XB_XCNT(j)]); sum += c; cnt += (c > 0u) ? 1u : 0u; mine = (j == x) ? c : mine; }
        if (sum == G) break;
        __builtin_amdgcn_s_sleep(1);
        if ((++sp & 255u) == 0u) { if (xb_ld(&bar[XB_TMO])) break; if (sp > XB_SPIN_CAP) { atomicAdd(&bar[XB_TMO], 1u); break; } }
    }
    nloc = mine > 0u ? mine : 1u; nx = cnt > 0u ? cnt : 1u;
}

__device__ __forceinline__ void xcd_barrier(const XcdBarrier& b) {
    asm volatile("s_waitcnt vmcnt(0)" ::: "memory");
    __syncthreads();
    if (threadIdx.x == 0) {
        unsigned* bar = b.bar;
        __builtin_amdgcn_s_waitcnt(0);
        unsigned nloc = b.st[0], nx = b.st[1];
        if (nloc == 0u) { xcd_barrier_complete(bar, b.x, nloc, nx); b.st[0] = nloc; b.st[1] = nx; }
        const unsigned old = xb_add(&bar[XB_XSUB(b.x)], 1u);
        const unsigned gen = old / nloc;
        if (old + 1u == (gen + 1u) * nloc) {
            __builtin_amdgcn_fence(__ATOMIC_RELEASE, "agent");
            asm volatile("s_waitcnt vmcnt(0)" ::: "memory");
            const unsigned og = xb_add(&bar[XB_TOP], 1u);
            const unsigned tg = og / nx;
            if (og + 1u == (tg + 1u) * nx) xb_add(&bar[XB_TOPGEN], 1u);
            else XB_SPIN(xb_ld(&bar[XB_TOPGEN]) == tg, bar);
            __builtin_amdgcn_fence(__ATOMIC_ACQUIRE, "agent");
            xb_add(&bar[XB_XGEN(b.x)], 1u);
            asm volatile("s_waitcnt vmcnt(0)" ::: "memory");
        } else {
            XB_SPIN(xb_ld(&bar[XB_XGEN(b.x)]) == gen, bar);
            __builtin_amdgcn_fence(__ATOMIC_ACQUIRE, "agent");
            asm volatile("s_waitcnt vmcnt(0)" ::: "memory");
        }
    }
    __syncthreads();
}

struct Frame {
    LAS unsigned char* lds;
    volatile LAS unsigned* MISC;
    gu32* ctl;
    int tid, lane, wave, vcu, G;
};
struct Args { const float* in[15]; float* out; unsigned char* ws; int ph_lo, ph_hi, chunk, pad; };
#define P_xp (A.in[0])
#define P_xs (A.in[1])
#define P_w_in (A.in[2])
#define P_b_gates (A.in[3])
#define P_mh_norm_w (A.in[4])
#define P_q_norm_w (A.in[5])
#define P_k_norm_w (A.in[6])
#define P_w_out (A.in[7])
#define P_norm1_w (A.in[8])
#define P_norm2_w (A.in[9])
#define P_w_up (A.in[10])
#define P_conv_w (A.in[11])
#define P_conv_b (A.in[12])
#define P_w_down (A.in[13])
#define P_final_norm_w (A.in[14])
#define P_out (A.out)
#define P_WIN ((bf16*)(A.ws + WS_WIN))
#define P_WOUT ((bf16*)(A.ws + WS_WOUT))
#define P_WUP ((bf16*)(A.ws + WS_WUP))
#define P_WDN ((bf16*)(A.ws + WS_WDN))
#define P_KV ((bf16*)(A.ws + WS_KV))
#define P_XN ((bf16*)(A.ws + WS_XN))
#define P_MIX ((bf16*)(A.ws + WS_MIX))
#define P_MK ((bf16*)(A.ws + WS_MK))
#define P_MV ((bf16*)(A.ws + WS_MV))
#define P_MO ((bf16*)(A.ws + WS_MO))
#define P_U ((bf16*)(A.ws + WS_U))
#define P_ACT ((bf16*)(A.ws + WS_ACT))
#define P_ROPE ((float*)(A.ws + WS_ROPE))
#define P_PART1 ((float*)(A.ws + WS_PART1))
#define P_PART2 ((float*)(A.ws + WS_PART2))
#define P_GT ((float*)(A.ws + WS_G))
#define P_HF ((float*)(A.ws + WS_HF))
__device__ __constant__ float ROPE_INV[16] = {1.0f, 0.5623413251903491f, 0.31622776601683794f, 0.1778279410038923f, 0.1f, 0.05623413251903491f, 0.03162277660168379f, 0.01778279410038923f,
                                              0.01f, 0.005623413251903491f, 0.003162277660168379f, 0.001778279410038923f, 0.001f, 0.0005623413251903491f, 0.00031622776601683794f, 0.0001778279410038923f};
constexpr float C2Q = 0.125f * 1.4426950408889634f;

__device__ __forceinline__ float wave_sum(float v) {
#pragma unroll
    for (int o = 1; o < 64; o <<= 1) v += __shfl_xor(v, o);
    return v;
}
__device__ __forceinline__ void transpose_item(const float* src, int sstride, const float* kscale, bf16* dst, int dpitch, int k0, LAS float* scr, int lane) {
#pragma unroll 8
    for (int i = 0; i < 32; ++i) { const int kk = 2 * i + (lane >> 5); float v = src[(size_t)(k0 + kk) * sstride + (lane & 31)]; if (kscale) v *= kscale[k0 + kk]; scr[kk * 33 + (lane & 31)] = v; }
    LDS_WAIT(); asm volatile("" ::: "memory");
    const int c = lane & 7;
#pragma unroll
    for (int j = 0; j < 4; ++j) { const int n = (lane >> 3) + 8 * j; const LAS float* s = scr + (8 * c) * 33 + n;
        v4u o; o.x = pk2(s[0 * 33], s[1 * 33]); o.y = pk2(s[2 * 33], s[3 * 33]); o.z = pk2(s[4 * 33], s[5 * 33]); o.w = pk2(s[6 * 33], s[7 * 33]);
        *(GAS v4u*)(dst + (size_t)n * dpitch + k0 + 8 * c) = o; }
    LDS_WAIT(); asm volatile("" ::: "memory");
}
__device__ __forceinline__ void rope_entry(float* ROPE, int e) {
    const int idx = e >> 4, i = e & 15; const int pos = idx < 256 ? idx : idx - 256;
    const float ang = (float)pos * ROPE_INV[i];
    const double TWO_PI = 6.283185307179586476925;
    const double a = (double)ang, k = rint(a * (1.0 / TWO_PI)), r = a - k * TWO_PI;
    const double x = r * 0.25, x2 = x * x;
    const double s = x * (1.0 + x2 * (-1.0 / 6 + x2 * (1.0 / 120 + x2 * (-1.0 / 5040 + x2 * (1.0 / 362880 + x2 * (-1.0 / 39916800 + x2 * (1.0 / 6227020800.0)))))));
    const double c = 1.0 + x2 * (-0.5 + x2 * (1.0 / 24 + x2 * (-1.0 / 720 + x2 * (1.0 / 40320 + x2 * (-1.0 / 3628800 + x2 * (1.0 / 479001600.0 + x2 * (-1.0 / 87178291200.0)))))));
    const double s2 = 2 * s * c, c2 = 1 - 2 * s * s, s4 = 2 * s2 * c2, c4 = 1 - 2 * s2 * s2;
    ROPE[2 * e] = (float)c4; ROPE[2 * e + 1] = (float)s4;
}
__device__ __forceinline__ void rms_row_to_bf16(const float* xrow, const float* w, bf16* orow, int lane) {
    const GAS f32x4* xr = (const GAS f32x4*)xrow + lane; const GAS f32x4* wr = (const GAS f32x4*)w + lane;
    f32x4 v[4]; float s = 0.f;
#pragma unroll
    for (int j = 0; j < 4; ++j) { v[j] = xr[64 * j]; s += (v[j].x * v[j].x + v[j].y * v[j].y) + (v[j].z * v[j].z + v[j].w * v[j].w); }
    const float rinv = 1.f / sqrtf(wave_sum(s) * (1.f / DM) + EPS);
    GAS unsigned long long* o8 = (GAS unsigned long long*)orow + lane;
#pragma unroll
    for (int j = 0; j < 4; ++j) { const f32x4 ww = wr[64 * j];
        o8[64 * j] = (unsigned long long)pk2(v[j].x * rinv * ww.x, v[j].y * rinv * ww.y) | ((unsigned long long)pk2(v[j].z * rinv * ww.z, v[j].w * rinv * ww.w) << 32); }
}
__device__ __forceinline__ void p0_prologue(Frame& F, const Args& A) {
    LAS float* scr = (LAS float*)(F.lds + RING_OFF + F.wave * 16384);
    const int gw = F.vcu * NWAVES + F.wave, NGW = F.G * NWAVES;
    constexpr int I_IN = 16 * 89, I_OUT = 16 * 32, I_UP = 16 * 176, I_DN = 44 * 32, NITEMS = I_IN + I_OUT + I_UP + I_DN;
    for (int it = gw; it < NITEMS; it += NGW) {
        int r = it;
        if (r < I_IN) { const int kb = r / 89, d0 = 32 * (r % 89);
            const int sc = d0 < 2048 ? d0 : d0 < 2560 ? 2080 + (d0 - 2048) : d0 < 2816 ? 2592 + (d0 - 2560) : 2048 + (d0 - 2816);
            transpose_item(P_w_in + sc, INC, nullptr, P_WIN + (size_t)d0 * DM, DM, 64 * kb, scr, F.lane); continue; } r -= I_IN;
        if (r < I_OUT) { const int kb = r / 32, d0 = 32 * (r % 32); transpose_item(P_w_out + d0, DM, nullptr, P_WOUT + (size_t)d0 * DM, DM, 64 * kb, scr, F.lane); continue; } r -= I_OUT;
        if (r < I_UP) { const int kb = r / 176, nb = r % 176, tile = nb >> 3, wi = nb & 7; const int sc = wi < 4 ? 128 * tile + 32 * wi : FF + 128 * tile + 32 * (wi - 4);
            transpose_item(P_w_up + sc, FF2, P_norm2_w, P_WUP + (size_t)(32 * nb) * DM, DM, 64 * kb, scr, F.lane); continue; } r -= I_UP;
        { const int kb = r / 32, d0 = 32 * (r % 32); transpose_item(P_w_down + d0, DM, nullptr, P_WDN + (size_t)d0 * FF, FF, 64 * kb, scr, F.lane); }
    }
    const int gt = gw * 64 + F.lane, NTH = NGW * 64;
    for (int i = gt; i < (INP - INC) * DM / 8; i += NTH) ((GAS v4u*)(P_WIN + (size_t)INC * DM))[i] = (v4u){0u, 0u, 0u, 0u};
    for (int e = gt; e < 320 * 16; e += NTH) rope_entry(P_ROPE, e);
    for (int m = gw; m < M; m += NGW) rms_row_to_bf16(m < T0 ? P_xp + (size_t)m * DM : P_xs + (size_t)(m - T0) * DM, P_norm1_w, P_XN + (size_t)m * DM, F.lane);
}
__device__ __forceinline__ void rope8(v4u& w, const float* nw, const float* cs, const float* sn, bool second, float outscale) {
    float x[8] = {bflo(w.x), bfhi(w.x), bflo(w.y), bfhi(w.y), bflo(w.z), bfhi(w.z), bflo(w.w), bfhi(w.w)};
    float ss = 0.f;
#pragma unroll
    for (int j = 0; j < 8; ++j) ss += x[j] * x[j];
    ss += __shfl_xor(ss, 1); ss += __shfl_xor(ss, 2); ss += __shfl_xor(ss, 4);
    const float rinv = 1.f / sqrtf(ss * (1.f / 64.f) + EPS);
    float o[8];
#pragma unroll
    for (int j = 0; j < 8; ++j) { const float y = x[j] * rinv * nw[j]; const float p = __shfl_xor(y, 2); o[j] = (second ? y * cs[j] + p * sn[j] : y * cs[j] - p * sn[j]) * outscale; }
    w.x = pk2(o[0], o[1]); w.y = pk2(o[2], o[3]); w.z = pk2(o[4], o[5]); w.w = pk2(o[6], o[7]);
}
__device__ __forceinline__ void p2_rope(Frame& F, const Args& A) {
    const int gw = F.vcu * NWAVES + F.wave, NGW = F.G * NWAVES, lane = F.lane;
    const int sub = lane & 7; const bool second = (sub & 2) != 0, colpart = sub >= 4; const int i0 = 8 * (sub & 1);
    float qw[8], kw[8];
#pragma unroll
    for (int j = 0; j < 8; ++j) { qw[j] = P_q_norm_w[8 * sub + j]; kw[j] = P_k_norm_w[8 * sub + j]; }
    for (int m = gw; m < M; m += NGW) {
        const int t = m < T0 ? m : ((m - T0) & (T1 - 1));
        const int tidx = colpart ? 256 + (t & 63) : (t >> 6);
        const GAS f32x4* tab = (const GAS f32x4*)(P_ROPE + (size_t)(tidx * 16 + i0) * 2);
        float cs[8], sn[8];
#pragma unroll
        for (int j = 0; j < 4; ++j) { const f32x4 v = tab[j]; cs[2 * j] = v.x; sn[2 * j] = v.y; cs[2 * j + 1] = v.z; sn[2 * j + 1] = v.w; }
        { GAS v4u* p = (GAS v4u*)(P_MIX + (size_t)m * DM + 512) + lane; v4u w = *p; rope8(w, qw, cs, sn, second, C2Q); *p = w; }
        if (lane < 16) { GAS v4u* p = (GAS v4u*)(P_KV + (size_t)m * 256) + lane; v4u w = *p; rope8(w, kw, cs, sn, second, 1.0f); *p = w; }
    }
}
__device__ __forceinline__ void p3_mlstm_naive(Frame& F, const Args& A) {
    LAS float* red = (LAS float*)(F.lds);
    LAS float* dred = red + 1024;
    const int tid = F.tid, dv = tid & 63, dkg = F.wave;
    for (int item = blockIdx.x; item < 17 * 8; item += F.G) {
        const int seq = item >> 3, h = item & 7;
        const int T = seq == 0 ? T0 : T1; const long rowbase = seq == 0 ? 0 : T0 + (long)(seq - 1) * T1;
        const float mhw = P_mh_norm_w[h * 64 + dv];
        for (int dir = 0; dir < 2; ++dir) {
            float C[8], nn[8]; float m = 0.f;
#pragma unroll
            for (int i = 0; i < 8; ++i) { C[i] = 0.f; nn[i] = 0.f; }
            const int gi = dir * 8 + h, gf = 16 + dir * 8 + h;
            long row = rowbase + (dir ? T - 1 : 0);
            v4u kw = *(const GAS v4u*)(P_MK + row * 512 + h * 64 + dkg * 8), qw = *(const GAS v4u*)(P_MIX + row * DM + h * 64 + dkg * 8);
            unsigned short vv = P_MV[row * 512 + h * 64 + dv]; float ig = P_GT[row * 32 + gi], fg = P_GT[row * 32 + gf];
            for (int step = 0; step < T; ++step) {
                const long rowc = row; const v4u kc = kw, qc = qw; const float vc = bf2f(vv), igc = ig, fgc = fg;
                if (step + 1 < T) { row = rowbase + (dir ? T - 2 - step : step + 1);
                    kw = *(const GAS v4u*)(P_MK + row * 512 + h * 64 + dkg * 8); qw = *(const GAS v4u*)(P_MIX + row * DM + h * 64 + dkg * 8);
                    vv = P_MV[row * 512 + h * 64 + dv]; ig = P_GT[row * 32 + gi]; fg = P_GT[row * 32 + gf]; }
                const float logf = fgc < 0.f ? fgc - log1pf(expf(fgc)) : -log1pf(expf(-fgc));
                const float m_new = fmaxf(logf + m, igc), a = expf(logf + m - m_new), b = expf(igc - m_new); m = m_new;
                const float k[8] = {bflo(kc.x), bfhi(kc.x), bflo(kc.y), bfhi(kc.y), bflo(kc.z), bfhi(kc.z), bflo(kc.w), bfhi(kc.w)};
                const float q[8] = {bflo(qc.x), bfhi(qc.x), bflo(qc.y), bfhi(qc.y), bflo(qc.z), bfhi(qc.z), bflo(qc.w), bfhi(qc.w)};
                float pn = 0.f, pd = 0.f;
#pragma unroll
                for (int i = 0; i < 8; ++i) { const float bk = b * k[i]; C[i] = a * C[i] + bk * vc; nn[i] = a * nn[i] + bk; pn += q[i] * C[i]; pd += q[i] * nn[i]; }
                const int buf = step & 1; red[buf * 512 + dkg * 64 + dv] = pn; if (dv == 0) dred[buf * 8 + dkg] = pd;
                __syncthreads();
                if (tid < 64) {
                    float num = 0.f, den = 0.f;
#pragma unroll
                    for (int g = 0; g < 8; ++g) { num += red[buf * 512 + g * 64 + dv]; den += dred[buf * 8 + g]; }
                    const float hval = num / fmaxf(fabsf(den), expf(-m));
                    if (dir == 0) P_HF[rowc * 512 + h * 64 + dv] = hval;
                    else { const float hs = hval + P_HF[rowc * 512 + h * 64 + dv]; const float ss = wave_sum(hs * hs);
                        const float y = hs / sqrtf(ss * (1.f / 64.f) + EPS) * mhw; const float mo = bf2f(P_MO[rowc * 512 + h * 64 + dv]);
                        P_MIX[rowc * DM + h * 64 + dv] = (bf16)f2bf(y / (1.f + expf(-mo))); }
                }
            }
            __syncthreads();
        }
    }
}
__device__ __forceinline__ void unpack8(const v4u w, float* x) { x[0] = bflo(w.x); x[1] = bfhi(w.x); x[2] = bflo(w.y); x[3] = bfhi(w.y); x[4] = bflo(w.z); x[5] = bfhi(w.z); x[6] = bflo(w.w); x[7] = bfhi(w.w); }
__device__ __forceinline__ void conv_chunk(Frame& F, const Args& A, int c) {
    const int gt = (F.vcu * NWAVES + F.wave) * 64 + F.lane, NTH = F.G * NWAVES * 64;
    const int Tseq = c == 0 ? T0 : T1;
    const v4u Z = (v4u){0u, 0u, 0u, 0u};
    for (int ti = gt; ti < 256 * 352; ti += NTH) {
        const int cg = ti % 352, seg = ti / 352, j0 = 8 * cg, tile = j0 >> 7, jj = j0 & 127;
        const int ca = tile * 256 + jj;
        float wa[3][8], wg[3][8], ba[8], bg[8];
#pragma unroll
        for (int j = 0; j < 8; ++j) {
#pragma unroll
            for (int tp = 0; tp < 3; ++tp) { wa[tp][j] = P_conv_w[tp * FF2 + j0 + j]; wg[tp][j] = P_conv_w[tp * FF2 + FF + j0 + j]; }
            ba[j] = P_conv_b[j0 + j]; bg[j] = P_conv_b[FF + j0 + j]; }
        const int r0 = seg * 64, p0 = r0 & (Tseq - 1);
        const bf16* Ua = P_U + (size_t)r0 * FF2 + ca; const bf16* Ug = Ua + 128;
        v4u pa = Z, pg = Z;
        if (p0 > 0) { pa = *(const GAS v4u*)(Ua - FF2); pg = *(const GAS v4u*)(Ug - FF2); }
        v4u cua = *(const GAS v4u*)Ua, cug = *(const GAS v4u*)Ug;
        for (int i = 0; i < 64; ++i) {
            v4u na = Z, ng = Z;
            if (i < 63 || p0 + 64 < Tseq) { na = *(const GAS v4u*)(Ua + (size_t)(i + 1) * FF2); ng = *(const GAS v4u*)(Ug + (size_t)(i + 1) * FF2); }
            float xp[8], xc[8], xn[8], yp[8], yc[8], yn[8], o[8];
            unpack8(pa, xp); unpack8(cua, xc); unpack8(na, xn); unpack8(pg, yp); unpack8(cug, yc); unpack8(ng, yn);
#pragma unroll
            for (int j = 0; j < 8; ++j) { const float a = wa[0][j] * xp[j] + wa[1][j] * xc[j] + wa[2][j] * xn[j] + ba[j];
                const float g = wg[0][j] * yp[j] + wg[1][j] * yc[j] + wg[2][j] * yn[j] + bg[j]; o[j] = a * g / (1.f + expf(-g)); }
            v4u w; w.x = pk2(o[0], o[1]); w.y = pk2(o[2], o[3]); w.z = pk2(o[4], o[5]); w.w = pk2(o[6], o[7]);
            *(GAS v4u*)(P_ACT + (size_t)(r0 + i) * FF + j0) = w;
            pa = cua; pg = cug; cua = na; cug = ng;
        }
    }
}
__device__ __forceinline__ void p4_attn_naive(Frame& F, const Args& A) {
    LAS bf16* Ks = (LAS bf16*)F.lds; LAS bf16* Vs = Ks + 4096; LAS float* red = (LAS float*)(F.lds + 16384);
    const int tid = F.tid, qi = tid & 63, part = F.wave;
    for (int item = blockIdx.x; item < (M / 64) * 8; item += F.G) {
        const int h = item & 7, rb = item >> 3; const long row0 = (long)rb * 64;
        const long seqbase = row0 < T0 ? 0 : T0 + ((row0 - T0) / T1) * T1; const int NT = row0 < T0 ? T0 / 64 : T1 / 64;
        float q[64], o[64]; float l = 0.f;
        { const GAS v4u* qp = (const GAS v4u*)(P_MIX + (row0 + qi) * DM + 512 + h * 64);
#pragma unroll
          for (int c = 0; c < 8; ++c) { float t[8]; unpack8(qp[c], t);
#pragma unroll
              for (int j = 0; j < 8; ++j) { q[8 * c + j] = t[j]; o[8 * c + j] = 0.f; } } }
        const int kvh = h >> 2;
        for (int kt = 0; kt < NT; ++kt) {
            __syncthreads();
            { const long kr = seqbase + (long)kt * 64 + (tid >> 3); const int ch = tid & 7;
              *(LAS v4u*)(Ks + (tid >> 3) * 64 + ch * 8) = *(const GAS v4u*)(P_KV + kr * 256 + kvh * 64 + ch * 8);
              *(LAS v4u*)(Vs + (tid >> 3) * 64 + ch * 8) = *(const GAS v4u*)(P_KV + kr * 256 + 128 + kvh * 64 + ch * 8); }
            __syncthreads();
            for (int kk = 0; kk < 8; ++kk) { const int key = part * 8 + kk; float s = 0.f;
#pragma unroll
                for (int c = 0; c < 8; ++c) { float t[8]; unpack8(*(const LAS v4u*)(Ks + key * 64 + c * 8), t);
#pragma unroll
                    for (int j = 0; j < 8; ++j) s += q[8 * c + j] * t[j]; }
                const float pw = exp2f(s); l += pw;
#pragma unroll
                for (int c = 0; c < 8; ++c) { float t[8]; unpack8(*(const LAS v4u*)(Vs + key * 64 + c * 8), t);
#pragma unroll
                    for (int j = 0; j < 8; ++j) o[8 * c + j] += pw * t[j]; } }
        }
        for (int pp = 1; pp < 8; ++pp) {
            __syncthreads();
            if (part == pp) {
#pragma unroll
                for (int d = 0; d < 64; ++d) red[qi * 66 + d] = o[d];
                red[qi * 66 + 64] = l; }
            __syncthreads();
            if (part == 0) {
#pragma unroll
                for (int d = 0; d < 64; ++d) o[d] += red[qi * 66 + d];
                l += red[qi * 66 + 64]; }
        }
        if (part == 0) { const float rl = 1.f / l; GAS v4u* op = (GAS v4u*)(P_MIX + (row0 + qi) * DM + 512 + h * 64);
#pragma unroll
            for (int c = 0; c < 8; ++c) { v4u w; w.x = pk2(o[8 * c] * rl, o[8 * c + 1] * rl); w.y = pk2(o[8 * c + 2] * rl, o[8 * c + 3] * rl); w.z = pk2(o[8 * c + 4] * rl, o[8 * c + 5] * rl); w.w = pk2(o[8 * c + 6] * rl, o[8 * c + 7] * rl); op[c] = w; } }
        __syncthreads();
    }
}
__device__ __forceinline__ void final_norm(Frame& F, const Args& A) {
    const int gw = F.vcu * NWAVES + F.wave, NGW = F.G * NWAVES, lane = F.lane;
    for (int m = gw; m < M; m += NGW) {
        const float ss = wave_sum(lane < 16 ? P_PART2[(size_t)m * 16 + lane] : 0.f);
        const float rinv = 1.f / sqrtf(ss * (1.f / DM) + EPS);
        GAS f32x4* row = (GAS f32x4*)(P_out + (size_t)m * DM) + lane; const GAS f32x4* wr = (const GAS f32x4*)P_final_norm_w + lane;
#pragma unroll
        for (int j = 0; j < 4; ++j) { const f32x4 v = row[64 * j], w = wr[64 * j]; row[64 * j] = v * rinv * w; }
    }
}

#ifndef MK_FUSED
#define MK_FUSED 0
#endif
constexpr int NPH = MK_FUSED ? 16 : 10;
__global__ void __launch_bounds__(NWAVES * 64, 2) enc_fwd(Args args) {
    extern __shared__ __attribute__((aligned(16))) unsigned char lds[];
    Frame F;
    F.lds = (LAS unsigned char*)lds;
    F.MISC = (volatile LAS unsigned*)(F.lds + MISC_OFF);
    F.tid = threadIdx.x; F.lane = F.tid & 63; F.wave = __builtin_amdgcn_readfirstlane(F.tid >> 6);
    F.G = gridDim.x; { const int bx = blockIdx.x; F.vcu = (F.G % 8 == 0) ? (bx % 8) * (F.G / 8) + bx / 8 : bx; }
    const Args& A = args;
    F.ctl = (gu32*)(args.ws + WS_CTL);
    for (int u = F.tid; u < (LDS_BYTES - LDSCTL_OFF) / 4; u += NWAVES * 64) ((LAS unsigned*)(F.lds + LDSCTL_OFF))[u] = 0u;
    __syncthreads();
    const int lo = args.ph_lo, hi = args.ph_hi;
    XcdBarrier bar; bar.bar = (unsigned*)(F.ctl + CW_BAR); bar.x = 0; bar.st = nullptr;
    if (hi - lo > 1) bar = xcd_barrier_post((unsigned*)(F.ctl + CW_BAR), F.MISC + 8);
#ifndef PHMASK
#define PHMASK 0xffff
#endif
#define IN(k) (((PHMASK >> (k)) & 1) && lo <= (k) && (k) < hi)
#define SEAM(k) do { if (IN(k) && IN((k) + 1)) xcd_barrier(bar); } while (0)

    if (IN(0)) { p0_prologue(F, A); SEAM(0); }
    if (IN(1)) {
        pg8::Gemm g{P_XN, P_WIN, M, INP, DM}; pg8::StaticOrder S; S.init(M, INP, F.G, (int)blockIdx.x);
        pg8::EpiIn E{P_MIX, P_MK, P_MV, P_MO, P_KV, P_GT, P_b_gates};
        pg8::gemm_phase<pg8::EpiIn, pg8::StaticOrder, true, true>(F.lds + RING_OFF, g, S, E);
        SEAM(1);
    }
#ifndef MLSTM_NAIVE
#define MLSTM_NAIVE 0
#endif
    if (IN(2)) { p2_rope(F, A);
        if (!MLSTM_NAIVE) for (int item = blockIdx.x; item < attn_body::mls::NITEM; item += F.G)
            attn_body::mls::m1_item(item, (const attn_body::bf16*)P_MK, (const attn_body::bf16*)P_MV, P_GT, P_HF, (char*)lds);
        SEAM(2); }
    if (IN(3)) { if (MLSTM_NAIVE) p3_mlstm_naive(F, A); else attn_body::mls::m2_scan(P_HF, (F.vcu * NWAVES + F.wave) * 64 + F.lane, F.G * NWAVES * 64); SEAM(3); }
#ifndef ATTN_NAIVE
#define ATTN_NAIVE 0
#endif
    if (IN(4) && ATTN_NAIVE) { p4_attn_naive(F, A); SEAM(4); }
    if (IN(4) && !ATTN_NAIVE) {
        const attn_body::UnitOrder S((int)F.G, F.vcu);
        attn_body::attn_phase<8>((char*)lds + RING_OFF, (const attn_body::bf16*)P_MIX, (const attn_body::bf16*)P_KV, (attn_body::bf16*)P_MIX, S);
        if (!MLSTM_NAIVE) for (int item = blockIdx.x; item < attn_body::mls::NITEM; item += F.G)
            attn_body::mls::m3_item(item, (const attn_body::bf16*)P_MIX, (const attn_body::bf16*)P_MK, (const attn_body::bf16*)P_MV, (const attn_body::bf16*)P_MO, P_GT, P_HF, P_mh_norm_w, (attn_body::bf16*)P_MIX, (char*)lds);
        SEAM(4);
    }
    if (IN(5)) {
        pg8::Gemm g{P_MIX, P_WOUT, M, DM, DM}; pg8::StaticOrder S; S.init(M, DM, F.G, (int)blockIdx.x);
        pg8::EpiRes<true> E{P_xp, P_xs, P_out, P_XN, P_PART1, 0};
        pg8::gemm_phase<pg8::EpiRes<true>, pg8::StaticOrder, true, true>(F.lds + RING_OFF, g, S, E);
        SEAM(5);
    }
#if MK_FUSED
#define FFN_CHUNK(c, base) do { const int row_off = (c) * 16384; \
        if (IN(base)) { pg8::Gemm g{P_XN + (size_t)row_off * DM, P_WUP, 16384, FF2, DM}; pg8::StaticOrder S; S.init(16384, FF2, F.G, (int)blockIdx.x); \
            pg8::EpiUp E{P_U, P_PART1, row_off, FF2}; pg8::gemm_phase<pg8::EpiUp, pg8::StaticOrder, true, true>(F.lds + RING_OFF, g, S, E); SEAM(base); } \
        if (IN((base) + 1)) { conv_chunk(F, A, (c)); SEAM((base) + 1); } \
        if (IN((base) + 2)) { pg8::Gemm g{P_ACT, P_WDN, 16384, DM, FF}; pg8::StaticOrder S; S.init(16384, DM, F.G, (int)blockIdx.x); \
            pg8::EpiRes<false> E{P_out, P_out + (size_t)T0 * DM, P_out, nullptr, P_PART2, row_off}; pg8::gemm_phase<pg8::EpiRes<false>, pg8::StaticOrder, true, true>(F.lds + RING_OFF, g, S, E); SEAM((base) + 2); } } while (0)
    FFN_CHUNK(0, 6); FFN_CHUNK(1, 9); FFN_CHUNK(2, 12);
    if (IN(15)) final_norm(F, A);
#else
    {
        const int c = A.chunk, row_off = c * 16384;
        if (IN(6)) {
            pg8::Gemm g{P_XN + (size_t)row_off * DM, P_WUP, 16384, FF2, DM}; pg8::StaticOrder S; S.init(16384, FF2, F.G, (int)blockIdx.x);
            pg8::EpiUp E{P_U, P_PART1, row_off, FF2};
            pg8::gemm_phase<pg8::EpiUp, pg8::StaticOrder, true, true>(F.lds + RING_OFF, g, S, E);
        }
        if (IN(7)) { conv_chunk(F, A, c); }
        if (IN(8)) {
            pg8::Gemm g{P_ACT, P_WDN, 16384, DM, FF}; pg8::StaticOrder S; S.init(16384, DM, F.G, (int)blockIdx.x);
            pg8::EpiRes<false> E{P_out, P_out + (size_t)T0 * DM, P_out, nullptr, P_PART2, row_off};
            pg8::gemm_phase<pg8::EpiRes<false>, pg8::StaticOrder, true, true>(F.lds + RING_OFF, g, S, E);
        }
    }
    if (IN(9)) final_norm(F, A);
#endif
#undef IN
#undef SEAM
}

extern "C" void kernel_launch(void* const* d_in, const int* in_sizes, int n_in, void* d_out, int out_size, void* d_ws, size_t ws_size, hipStream_t stream) {
    static int grid = 0;
    if (grid == 0) {
        if (n_in != 15 || in_sizes[0] != T0 * DM || in_sizes[1] != NSEQ1 * T1 * DM || out_size != M * DM || ws_size < WS_END) {
            fprintf(stderr, "kernel_launch: unexpected shapes (n_in %d, in0 %d, out %d, ws %zu); nothing launched\n", n_in, n_in > 0 ? in_sizes[0] : -1, out_size, ws_size); grid = -1; return; }
        int dev = 0, cus = 0, per_cu = 0;
        if (hipGetDevice(&dev) != hipSuccess || hipDeviceGetAttribute(&cus, hipDeviceAttributeMultiprocessorCount, dev) != hipSuccess) { grid = -1; return; }
        if (hipFuncSetAttribute((const void*)enc_fwd, hipFuncAttributeMaxDynamicSharedMemorySize, LDS_BYTES) != hipSuccess) { fprintf(stderr, "kernel_launch: hipFuncSetAttribute failed\n"); grid = -1; return; }
        if (hipOccupancyMaxActiveBlocksPerMultiprocessor(&per_cu, (const void*)enc_fwd, NWAVES * 64, LDS_BYTES) != hipSuccess || per_cu < 1)
            fprintf(stderr, "kernel_launch: note: occupancy query reports %d workgroups per CU\n", per_cu);
        (void)hipGetLastError();
        grid = cus;
    }
    if (grid < 0) return;
    if (hipMemsetAsync((char*)d_ws + WS_CTL, 0, CTL_ZERO_BYTES, stream) != hipSuccess) { fprintf(stderr, "kernel_launch: hipMemsetAsync failed\n"); return; }
    Args a{};
    for (int i = 0; i < 15; ++i) a.in[i] = (const float*)d_in[i];
    a.out = (float*)d_out; a.ws = (unsigned char*)d_ws;
#if MK_FUSED
    a.ph_lo = 0; a.ph_hi = NPH;
    hipLaunchKernelGGL(enc_fwd, dim3(grid), dim3(NWAVES * 64), LDS_BYTES, stream, a);
#else
    for (int ph = 0; ph < 6; ++ph) { a.ph_lo = ph; a.ph_hi = ph + 1; hipLaunchKernelGGL(enc_fwd, dim3(grid), dim3(NWAVES * 64), LDS_BYTES, stream, a); }
    for (int c = 0; c < 3; ++c) for (int ph = 6; ph < 9; ++ph) { a.ph_lo = ph; a.ph_hi = ph + 1; a.chunk = c; hipLaunchKernelGGL(enc_fwd, dim3(grid), dim3(NWAVES * 64), LDS_BYTES, stream, a); }
    a.ph_lo = 9; a.ph_hi = 10; a.chunk = 0; hipLaunchKernelGGL(enc_fwd, dim3(grid), dim3(NWAVES * 64), LDS_BYTES, stream, a);
#endif
    const hipError_t le = hipPeekAtLastError();
    if (le != hipSuccess) fprintf(stderr, "kernel_launch: launch failed: %s\n", hipGetErrorName(le));
}
```

```cpp
#define MK_FUSED 1
#include <hip/hip_runtime.h>
#include <hip/hip_bf16.h>
#include <cstdio>
#include <cstdint>
#include <cmath>
namespace pg8 {
#define PG8_LAS __attribute__((address_space(3)))
typedef unsigned short bf16_t;
typedef short bf16x8 __attribute__((ext_vector_type(8)));
typedef float f32x4 __attribute__((ext_vector_type(4)));
typedef unsigned u32x4 __attribute__((ext_vector_type(4)));
constexpr int BM = 256, BK = 64, HALF = 128, HTB = HALF * BK * 2  , STAGE_BYTES = 8 * HTB, NXCD = 8, WGM = 8;

__host__ __device__ __forceinline__ int lds_byte(int r, int c) { const int st = (r >> 4) * 2 + (c >> 5), rr = r & 15, cc = c & 31, ob = rr * 64 + cc * 2; return st * 1024 + (ob ^ (((ob >> 9) & 1) << 5)); }
__host__ __device__ __forceinline__ void stage_rc(int b, int& R, int& C) { const int st = b / 1024, sb = b % 1024, swz = sb ^ (((sb >> 9) & 1) << 5); R = (st >> 1) * 16 + swz / 64; C = (st & 1) * 32 + (swz % 64) / 2; }
__host__ __device__ __forceinline__ int perm32(int rho) { const int n = rho >> 4, i = rho & 15; return 8 * (i >> 2) + 4 * n + (i & 3); }

struct Unit { int pm, pn; };
struct Gemm { const bf16_t* A; const bf16_t* Bt; int M, N, K; };

struct StaticOrder {
    int nM, nN, nwg, G, c;
    __host__ __device__ void init(int M, int N, int G_, int c_) { nM = M / BM; nN = N / BM; nwg = nM * nN; G = G_; c = c_; }
    __host__ __device__ bool next(int i, Unit& u) const {
        const long L = (long)i * G + c; if (L >= nwg) return false;
        int wgid = (int)L; { const int q = nwg / NXCD, r = nwg % NXCD, xcd = wgid % NXCD, off = wgid / NXCD; wgid = (xcd < r ? xcd * (q + 1) : r * (q + 1) + (xcd - r) * q) + off; }
        const int nig = WGM * nN, gid = wgid / nig, fm = gid * WGM, gsz = (nM - fm) < WGM ? (nM - fm) : WGM;
        u.pm = fm + ((wgid % nig) % gsz); u.pn = (wgid % nig) / gsz; return true;
    }
    __device__ __forceinline__ void a_ready(const Unit&) const {}
    __device__ __forceinline__ void done(const Unit&) const {}
};

__device__ __forceinline__ unsigned cvt_pk_bf16(float lo, float hi) { unsigned r; asm volatile("v_cvt_pk_bf16_f32 %0, %1, %2" : "=v"(r) : "v"(lo), "v"(hi)); return r; }
typedef float f32x2 __attribute__((ext_vector_type(2)));
constexpr int T0_ROWS = 16384;
struct EpiIn {
    static constexpr bool PERM = true, APERM = false, AFTER_DRAIN = false;
    bf16_t *MIX, *MK, *MV, *MO, *KV; float* G; const float* bg;
    __device__ __forceinline__ void operator()(const f32x4 (&acc)[2][2][4][2], const Unit& u, int wr, int wc, int fr, int fq) const {
        const int row0 = u.pm * BM + wr * 64 + fr; const int pn = u.pn;
        if (pn == 11) {
            if (wc == 0) {
                const f32x4 b0 = *(const f32x4*)(bg + 8 * fq), b1 = *(const f32x4*)(bg + 8 * fq + 4);
#pragma unroll
                for (int ai = 0; ai < 2; ++ai)
#pragma unroll
                    for (int m = 0; m < 4; ++m) { float* gp = G + (size_t)(row0 + ai * HALF + m * 16) * 32 + 8 * fq;
                        *(f32x4*)gp = acc[ai][0][m][0] + b0; *(f32x4*)(gp + 4) = acc[ai][0][m][1] + b1; }
            }
            return;
        }
        bf16_t* base; int ldc; float sc = 1.f;
        if (pn < 2) { base = MIX + pn * 256; ldc = 1024; }
        else if (pn < 4) { base = MK + (pn - 2) * 256; ldc = 512; sc = 0.125f; }
        else if (pn < 6) { base = MV + (pn - 4) * 256; ldc = 512; }
        else if (pn < 8) { base = MO + (pn - 6) * 256; ldc = 512; }
        else if (pn < 10) { base = MIX + 512 + (pn - 8) * 256; ldc = 1024; }
        else { base = KV; ldc = 256; }
        const int col0 = wc * 32 + 8 * fq;
#pragma unroll
        for (int ai = 0; ai < 2; ++ai)
#pragma unroll
            for (int m = 0; m < 4; ++m) { bf16_t* rowp = base + (size_t)(row0 + ai * HALF + m * 16) * ldc + col0;
#pragma unroll
                for (int bj = 0; bj < 2; ++bj) { const f32x4 v0 = acc[ai][bj][m][0] * sc, v1 = acc[ai][bj][m][1] * sc;
                    u32x4 w; w.x = cvt_pk_bf16(v0[0], v0[1]); w.y = cvt_pk_bf16(v0[2], v0[3]); w.z = cvt_pk_bf16(v1[0], v1[1]); w.w = cvt_pk_bf16(v1[2], v1[3]);
                    *(u32x4*)(rowp + bj * HALF) = w; } }
    }
};
template <bool WRITE_B> struct EpiRes {
    static constexpr bool PERM = false, APERM = false, AFTER_DRAIN = false;
    const float* base0; const float* base1; float* out; bf16_t* xb; float* part; int row_off;
    __device__ __forceinline__ void operator()(const f32x4 (&acc)[2][2][4][2], const Unit& u, int wr, int wc, int fr, int fq) const {
        typedef unsigned u32x2v __attribute__((ext_vector_type(2)));
#pragma unroll
        for (int ai = 0; ai < 2; ++ai)
#pragma unroll
            for (int m = 0; m < 4; ++m) {
                const int r = row_off + u.pm * BM + ai * HALF + wr * 64 + m * 16 + fr;
                const float* brow = (r < T0_ROWS) ? base0 + (size_t)r * 1024 : base1 + (size_t)(r - T0_ROWS) * 1024;
                float ss = 0.f;
#pragma unroll
                for (int bj = 0; bj < 2; ++bj)
#pragma unroll
                    for (int n = 0; n < 2; ++n) { const int col = u.pn * BM + bj * HALF + wc * 32 + n * 16 + 4 * fq;
                        const f32x4 o = *(const f32x4*)(brow + col) + acc[ai][bj][m][n];
                        *(f32x4*)(out + (size_t)r * 1024 + col) = o; ss += (o[0] * o[0] + o[1] * o[1]) + (o[2] * o[2] + o[3] * o[3]);
                        if (WRITE_B) { u32x2v w; w.x = cvt_pk_bf16(o[0], o[1]); w.y = cvt_pk_bf16(o[2], o[3]); *(u32x2v*)(xb + (size_t)r * 1024 + col) = w; } }
                ss += __shfl_xor(ss, 16); ss += __shfl_xor(ss, 32);
                if (fq == 0) part[(size_t)r * 16 + u.pn * 4 + wc] = ss;
            }
    }
};
struct EpiUp {
    static constexpr bool PERM = true, APERM = false, AFTER_DRAIN = false;
    bf16_t* U; const float* part; int row_off; int ldu;
    __device__ __forceinline__ void operator()(const f32x4 (&acc)[2][2][4][2], const Unit& u, int wr, int wc, int fr, int fq) const {
        const int col0 = u.pn * BM + wc * 32 + 8 * fq;
#pragma unroll
        for (int ai = 0; ai < 2; ++ai)
#pragma unroll
            for (int m = 0; m < 4; ++m) { const int rl = u.pm * BM + ai * HALF + wr * 64 + m * 16 + fr;
                const f32x4* pp = (const f32x4*)(part + (size_t)(row_off + rl) * 16); const f32x4 a = pp[0], b = pp[1], c = pp[2], d = pp[3];
                const float ss = ((a[0] + a[1]) + (a[2] + a[3])) + ((b[0] + b[1]) + (b[2] + b[3])) + ((c[0] + c[1]) + (c[2] + c[3])) + ((d[0] + d[1]) + (d[2] + d[3]));
                const float rinv = 1.0f / sqrtf(ss * (1.0f / 1024.0f) + 1e-6f);
                bf16_t* rowp = U + (size_t)rl * ldu + col0;
#pragma unroll
                for (int bj = 0; bj < 2; ++bj) { const f32x4 v0 = acc[ai][bj][m][0] * rinv, v1 = acc[ai][bj][m][1] * rinv;
                    u32x4 w; w.x = cvt_pk_bf16(v0[0], v0[1]); w.y = cvt_pk_bf16(v0[2], v0[3]); w.z = cvt_pk_bf16(v1[0], v1[1]); w.w = cvt_pk_bf16(v1[2], v1[3]);
                    *(u32x4*)(rowp + bj * HALF) = w; } }
    }
};

struct EpiUpConv {
    static constexpr bool PERM = true, APERM = true, AFTER_DRAIN = false;
    bf16_t* ACT; const float* part; const float* cw; const float* cb; float* HALO; PG8_LAS float* EX;
    static __device__ __forceinline__ float dpp_shr1(float oldv, float src) { return __builtin_bit_cast(float, __builtin_amdgcn_update_dpp(__builtin_bit_cast(int, oldv), __builtin_bit_cast(int, src), 0x111, 0xf, 0xf, false)); }
    static __device__ __forceinline__ float dpp_shl1(float oldv, float src) { return __builtin_bit_cast(float, __builtin_amdgcn_update_dpp(__builtin_bit_cast(int, oldv), __builtin_bit_cast(int, src), 0x101, 0xf, 0xf, false)); }
    __device__ __forceinline__ void operator()(const f32x4 (&acc)[2][2][4][2], const Unit& u, int wr, int wc, int fr, int fq) const {
        const int FFW = 2816, cbase = wc * 32 + 8 * fq;
        f32x4 U[2][2][4][2];
#pragma unroll
        for (int ai = 0; ai < 2; ++ai) {
            const int r = u.pm * BM + ai * HALF + wr * 64 + 4 * fr + fq;
            const f32x4* pp = (const f32x4*)(part + (size_t)r * 16); const f32x4 a = pp[0], b = pp[1], c = pp[2], d = pp[3];
            const float ss = ((a[0] + a[1]) + (a[2] + a[3])) + ((b[0] + b[1]) + (b[2] + b[3])) + ((c[0] + c[1]) + (c[2] + c[3])) + ((d[0] + d[1]) + (d[2] + d[3]));
            const float rmine = 1.0f / sqrtf(ss * (1.0f / 1024.0f) + 1e-6f);
#pragma unroll
            for (int m = 0; m < 4; ++m) { const float rinv = __shfl(rmine, fr + 16 * m);
#pragma unroll
                for (int bj = 0; bj < 2; ++bj)
#pragma unroll
                    for (int n = 0; n < 2; ++n) U[ai][bj][m][n] = acc[ai][bj][m][n] * rinv; } }
        if (fr == 0) {
#pragma unroll
            for (int ai = 0; ai < 2; ++ai)
#pragma unroll
                for (int bj = 0; bj < 2; ++bj)
#pragma unroll
                    for (int n = 0; n < 2; ++n) *(PG8_LAS f32x4*)(EX + ((2 * ai + wr) * 2 + 0) * 256 + bj * 128 + cbase + 4 * n) = U[ai][bj][0][n];
            if (wr == 0) {
#pragma unroll
                for (int e = 0; e < 2; ++e)
#pragma unroll
                    for (int bj = 0; bj < 2; ++bj)
#pragma unroll
                        for (int n = 0; n < 2; ++n) *(f32x4*)(HALO + (((size_t)u.pm * 4 + e) * 2 + bj) * FFW + 128 * u.pn + cbase + 4 * n) = U[0][bj][e][n]; }
        }
        if (fr == 15) {
#pragma unroll
            for (int ai = 0; ai < 2; ++ai)
#pragma unroll
                for (int bj = 0; bj < 2; ++bj)
#pragma unroll
                    for (int n = 0; n < 2; ++n) *(PG8_LAS f32x4*)(EX + ((2 * ai + wr) * 2 + 1) * 256 + bj * 128 + cbase + 4 * n) = U[ai][bj][3][n];
            if (wr == 1) {
#pragma unroll
                for (int e = 0; e < 2; ++e)
#pragma unroll
                    for (int bj = 0; bj < 2; ++bj)
#pragma unroll
                        for (int n = 0; n < 2; ++n) *(f32x4*)(HALO + (((size_t)u.pm * 4 + 2 + e) * 2 + bj) * FFW + 128 * u.pn + cbase + 4 * n) = U[1][bj][2 + e][n]; }
        }
        asm volatile("s_waitcnt lgkmcnt(0)" ::: "memory"); __builtin_amdgcn_s_barrier(); asm volatile("" ::: "memory");
        typedef unsigned u32x2c __attribute__((ext_vector_type(2)));
#pragma unroll
        for (int n = 0; n < 2; ++n) {
            const int col = 128 * u.pn + cbase + 4 * n;
            f32x4 w[3][2], bb[2];
#pragma unroll
            for (int bj = 0; bj < 2; ++bj) { bb[bj] = *(const f32x4*)(cb + bj * FFW + col);
#pragma unroll
                for (int tp = 0; tp < 3; ++tp) w[tp][bj] = *(const f32x4*)(cw + tp * 2 * FFW + bj * FFW + col); }
#pragma unroll
            for (int ai = 0; ai < 2; ++ai) {
                const int blk = 2 * ai + wr;
                f32x4 ab[2], be[2];
#pragma unroll
                for (int bj = 0; bj < 2; ++bj) {
                    ab[bj] = blk > 0 ? *(const PG8_LAS f32x4*)(EX + ((blk - 1) * 2 + 1) * 256 + bj * 128 + cbase + 4 * n) : (f32x4){0.f, 0.f, 0.f, 0.f};
                    be[bj] = blk < 3 ? *(const PG8_LAS f32x4*)(EX + ((blk + 1) * 2 + 0) * 256 + bj * 128 + cbase + 4 * n) : (f32x4){0.f, 0.f, 0.f, 0.f}; }
#pragma unroll
                for (int m = 0; m < 4; ++m) {
                    f32x4 cv[2];
#pragma unroll
                    for (int bj = 0; bj < 2; ++bj) {
                        f32x4 prev, next; const f32x4 cur = U[ai][bj][m][n];
                        if (m > 0) prev = U[ai][bj][m - 1][n];
                        else {
#pragma unroll
                            for (int j = 0; j < 4; ++j) prev[j] = dpp_shr1(ab[bj][j], U[ai][bj][3][n][j]); }
                        if (m < 3) next = U[ai][bj][m + 1][n];
                        else {
#pragma unroll
                            for (int j = 0; j < 4; ++j) next[j] = dpp_shl1(be[bj][j], U[ai][bj][0][n][j]); }
                        cv[bj] = w[0][bj] * prev + w[1][bj] * cur + w[2][bj] * next + bb[bj]; }
                    float o[4];
#pragma unroll
                    for (int j = 0; j < 4; ++j) o[j] = cv[0][j] * cv[1][j] * __builtin_amdgcn_rcpf(1.0f + __expf(-cv[1][j]));
                    const int tr = ai * HALF + wr * 64 + 4 * fr + m;
                    if (tr != 0 && tr != 255) { u32x2c wv; wv.x = cvt_pk_bf16(o[0], o[1]); wv.y = cvt_pk_bf16(o[2], o[3]);
                        *(u32x2c*)(ACT + (size_t)(u.pm * BM + tr) * FFW + col) = wv; }
                }
            }
        }
    }
};

template <class Epi, class Sched, bool ALIGN_EPI = false, bool SP2 = false>
__device__ __forceinline__ void gemm_phase(PG8_LAS unsigned char* lds, const Gemm g, const Sched& S, const Epi& E) {
    const int tid = threadIdx.x, wid = __builtin_amdgcn_readfirstlane(tid >> 6), lane = tid & 63, wr = wid >> 2, wc = wid & 3, fr = lane & 15, fq = lane >> 4;
    const int K = g.K, nt = K / BK;
    unsigned voffA[2], voffB[2];
#pragma unroll
    for (int i = 0; i < 2; ++i) { int R, C; stage_rc(tid * 16 + i * 8192, R, C); const int Rb = Epi::PERM ? ((R & ~31) + perm32(R & 31)) : R;
        const int Ra = Epi::APERM ? ((R & ~63) + 4 * (R & 15) + ((R >> 4) & 3)) : R;
        voffA[i] = (unsigned)(Ra * K + C) * 2u; voffB[i] = (unsigned)(Rb * K + C) * 2u; }
    const size_t kstep = (size_t)(BK * 2);
    const size_t hstep = (size_t)HALF * K * 2;
    const size_t tstep = 2 * hstep;
    const unsigned ldsw = (unsigned)wid * 1024u;
    const int aoff = lds_byte(wr * 64 + fr, fq * 8), boff = lds_byte(wc * 32 + fr, fq * 8);
#define PG8_SA(b, h) (((b) * 2 + (h)) * HTB)
#define PG8_SB(b, h) ((4 + (b) * 2 + (h)) * HTB)
#define PG8_STAGE(bufoff, gbase, voff) do { _Pragma("unroll") for (int _i = 0; _i < 2; ++_i) \
        __builtin_amdgcn_global_load_lds((const unsigned*)((const char*)(gbase) + (voff)[_i]), (PG8_LAS unsigned*)(lds + (bufoff) + ldsw + _i * 8192), 16, 0, 0); } while (0)
#define PG8_LDA(dst, b, h) do { _Pragma("unroll") for (int m = 0; m < 4; ++m) _Pragma("unroll") for (int k = 0; k < 2; ++k) dst[m][k] = *(const PG8_LAS bf16x8*)(lds + PG8_SA(b, h) + aoff + m * 2048 + k * 1024); } while (0)
#define PG8_LDB(dst, b, h) do { _Pragma("unroll") for (int n = 0; n < 2; ++n) _Pragma("unroll") for (int k = 0; k < 2; ++k) dst[n][k] = *(const PG8_LAS bf16x8*)(lds + PG8_SB(b, h) + boff + n * 2048 + k * 1024); } while (0)
#define PG8_MMA(ai, bj, At, Bt) do { __builtin_amdgcn_s_setprio(1); _Pragma("unroll") for (int m = 0; m < 4; ++m) _Pragma("unroll") for (int n = 0; n < 2; ++n) _Pragma("unroll") for (int k = 0; k < 2; ++k) \
        acc[ai][bj][m][n] = __builtin_amdgcn_mfma_f32_16x16x32_bf16(Bt[n][k], At[m][k], acc[ai][bj][m][n], 0, 0, 0); __builtin_amdgcn_s_setprio(0); } while (0)
#define PG8_WAIT_V(n) asm volatile("s_waitcnt vmcnt(" #n ")" ::: "memory")
#define PG8_WAIT_L(n) asm volatile("s_waitcnt lgkmcnt(" #n ")" ::: "memory")
#define PG8_BAR __builtin_amdgcn_s_barrier()
#define PG8_SCHED __builtin_amdgcn_sched_barrier(0)
    Unit cur, nxt; int ui = 0;
    if (!S.next(0, cur)) return;
    f32x4 acc[2][2][4][2];
#pragma unroll
    for (int a = 0; a < 2; ++a)
#pragma unroll
        for (int b = 0; b < 2; ++b)
#pragma unroll
            for (int m = 0; m < 4; ++m)
#pragma unroll
                for (int n = 0; n < 2; ++n) acc[a][b][m][n] = (f32x4){0.f, 0.f, 0.f, 0.f};
    bf16x8 At[4][2], B0[2][2], B1[2][2];
    const char* cA = (const char*)g.A + (size_t)cur.pm * tstep; const char* cB = (const char*)g.Bt + (size_t)cur.pn * tstep;
    S.a_ready(cur);
    if constexpr (SP2) {
        PG8_STAGE(PG8_SB(0, 0), cB, voffB); PG8_STAGE(PG8_SB(0, 1), cB + hstep, voffB); PG8_STAGE(PG8_SA(0, 0), cA, voffA); PG8_STAGE(PG8_SA(0, 1), cA + hstep, voffA);
        if (wr == 1) PG8_BAR;
        PG8_WAIT_V(2); PG8_BAR;
        PG8_STAGE(PG8_SB(1, 0), cB + kstep, voffB); PG8_STAGE(PG8_SA(1, 0), cA + kstep, voffA); PG8_STAGE(PG8_SB(1, 1), cB + hstep + kstep, voffB);
        PG8_WAIT_V(6); PG8_BAR;
    } else {
        PG8_STAGE(PG8_SB(0, 0), cB, voffB); PG8_STAGE(PG8_SA(0, 0), cA, voffA); PG8_STAGE(PG8_SB(0, 1), cB + hstep, voffB); PG8_STAGE(PG8_SA(0, 1), cA + hstep, voffA);
        if (wr == 1) PG8_BAR;
        PG8_WAIT_V(4); PG8_BAR;
        PG8_STAGE(PG8_SB(1, 0), cB + kstep, voffB); PG8_STAGE(PG8_SA(1, 0), cA + kstep, voffA); PG8_STAGE(PG8_SB(1, 1), cB + hstep + kstep, voffB);
        PG8_WAIT_V(6); PG8_BAR;
    }
    for (;;) {
        const bool has_next = S.next(ui + 1, nxt);
        const char* nA = has_next ? (const char*)g.A + (size_t)nxt.pm * tstep : cA; const char* nB = has_next ? (const char*)g.Bt + (size_t)nxt.pn * tstep : cB;
        for (int t = 0; t < nt; t += 2) {
            const bool last = (t == nt - 2);
            const char* a1 = cA + (size_t)(t + 1) * kstep;
            const char* a2 = last ? nA : cA + (size_t)(t + 2) * kstep; const char* b2 = last ? nB : cB + (size_t)(t + 2) * kstep;
            const char* a3 = a2 + kstep; const char* b3 = b2 + kstep;
            if (last && has_next) S.a_ready(nxt);
            if constexpr (SP2) {
            PG8_LDB(B0, 0, 0); PG8_LDB(B1, 0, 1); PG8_SCHED; PG8_LDA(At, 0, 0); PG8_STAGE(PG8_SA(1, 1), a1 + hstep, voffA);
            PG8_WAIT_V(8); PG8_WAIT_L(0); PG8_BAR; PG8_MMA(0, 0, At, B0); PG8_MMA(0, 1, At, B1); PG8_BAR; PG8_SCHED;
            PG8_LDA(At, 0, 1); PG8_STAGE(PG8_SB(0, 0), b2, voffB); PG8_STAGE(PG8_SB(0, 1), b2 + hstep, voffB); PG8_STAGE(PG8_SA(0, 0), a2, voffA);
            PG8_WAIT_V(8); PG8_WAIT_L(0); PG8_BAR; PG8_MMA(1, 0, At, B0); PG8_MMA(1, 1, At, B1); PG8_BAR; PG8_SCHED;
            PG8_LDB(B0, 1, 0); PG8_LDB(B1, 1, 1); PG8_SCHED; PG8_LDA(At, 1, 0); PG8_STAGE(PG8_SA(0, 1), a2 + hstep, voffA);
            PG8_WAIT_V(8); PG8_WAIT_L(0); PG8_BAR; PG8_MMA(0, 0, At, B0); PG8_MMA(0, 1, At, B1); PG8_BAR; PG8_SCHED;
            PG8_LDA(At, 1, 1); PG8_STAGE(PG8_SB(1, 0), b3, voffB); PG8_STAGE(PG8_SB(1, 1), b3 + hstep, voffB); PG8_STAGE(PG8_SA(1, 0), a3, voffA);
            PG8_WAIT_V(8); PG8_WAIT_L(0); PG8_BAR; PG8_MMA(1, 0, At, B0); PG8_MMA(1, 1, At, B1); PG8_BAR; PG8_SCHED;
            } else {
            PG8_LDB(B0, 0, 0); PG8_SCHED; PG8_LDA(At, 0, 0); PG8_STAGE(PG8_SA(1, 1), a1 + hstep, voffA);
            PG8_WAIT_L(8); PG8_BAR; PG8_WAIT_L(0); PG8_MMA(0, 0, At, B0); PG8_BAR; PG8_SCHED;
            PG8_LDB(B1, 0, 1); PG8_STAGE(PG8_SB(0, 0), b2, voffB);
            PG8_BAR; PG8_WAIT_L(0); PG8_MMA(0, 1, At, B1); PG8_BAR;
            PG8_LDA(At, 0, 1); PG8_STAGE(PG8_SA(0, 0), a2, voffA);
            PG8_BAR; PG8_WAIT_L(0); PG8_MMA(1, 0, At, B0); PG8_BAR; PG8_SCHED;
            PG8_STAGE(PG8_SB(0, 1), b2 + hstep, voffB);
            PG8_WAIT_V(6); PG8_BAR; PG8_MMA(1, 1, At, B1); PG8_BAR;
            PG8_LDB(B0, 1, 0); PG8_SCHED; PG8_LDA(At, 1, 0); PG8_STAGE(PG8_SA(0, 1), a2 + hstep, voffA);
            PG8_WAIT_L(8); PG8_BAR; PG8_WAIT_L(0); PG8_MMA(0, 0, At, B0); PG8_BAR; PG8_SCHED;
            PG8_LDB(B1, 1, 1); PG8_STAGE(PG8_SB(1, 0), b3, voffB);
            PG8_BAR; PG8_WAIT_L(0); PG8_MMA(0, 1, At, B1); PG8_BAR;
            PG8_LDA(At, 1, 1); PG8_STAGE(PG8_SA(1, 0), a3, voffA);
            PG8_BAR; PG8_WAIT_L(0); PG8_MMA(1, 0, At, B0); PG8_BAR; PG8_SCHED;
            PG8_STAGE(PG8_SB(1, 1), b3 + hstep, voffB);
            PG8_WAIT_V(6); PG8_BAR; PG8_MMA(1, 1, At, B1); PG8_BAR;
            }
        }
        if constexpr (ALIGN_EPI) { if (wr == 0) PG8_BAR; }
        if constexpr (!Epi::AFTER_DRAIN) { E(acc, cur, wr, wc, fr, fq); S.done(cur); }
        if (!has_next) break;
#pragma unroll
        for (int a = 0; a < 2; ++a)
#pragma unroll
            for (int b = 0; b < 2; ++b)
#pragma unroll
                for (int m = 0; m < 4; ++m)
#pragma unroll
                    for (int n = 0; n < 2; ++n) acc[a][b][m][n] = (f32x4){0.f, 0.f, 0.f, 0.f};
        cur = nxt; cA = nA; cB = nB; ++ui;
        if constexpr (ALIGN_EPI) { if (wr == 1) PG8_BAR; }
    }
    PG8_WAIT_V(0);
    if constexpr (!ALIGN_EPI) { if (wr == 0) PG8_BAR; }
    PG8_BAR;
    if constexpr (Epi::AFTER_DRAIN) { E.fused(acc, cur, wr, wc, fr, fq, lds, wid, lane); S.done(cur); }
#undef PG8_SA
#undef PG8_SB
#undef PG8_STAGE
#undef PG8_LDA
#undef PG8_LDB
#undef PG8_MMA
#undef PG8_WAIT_V
#undef PG8_WAIT_L
#undef PG8_BAR
#undef PG8_SCHED
}
}

namespace attn_body {
using bf16=__hip_bfloat16;
using bf16x8=__attribute__((ext_vector_type(8)))short;
using s16x4=__attribute__((ext_vector_type(4)))short;
using f32x16=__attribute__((ext_vector_type(16)))float;
using u32x4=__attribute__((ext_vector_type(4)))unsigned;
constexpr int D=64,QP=1024,KVP=256;
constexpr int NW=8,QBLK=32,QB=QBLK*NW,KVBLK=64;
constexpr int ATTN_UNIT_ROWS=QB;
__device__ __forceinline__ int crow(int r,int hi){return (r&3)+8*(r>>2)+4*hi;}
#define SBAR() __builtin_amdgcn_sched_barrier(0)
__device__ __forceinline__ void cmask(f32x16&p0,f32x16&p1,int jb,int qrel,int hi){
  const float NEG=-INFINITY; int kb=64*jb+4*hi;
  #pragma unroll
  for(int r=0;r<16;++r){int kv=kb+(r&3)+8*(r>>2); if(kv>qrel)p0[r]=NEG; if(kv+32>qrel)p1[r]=NEG;}
}

constexpr int NSLOT=3, SLOTB=8192;
constexpr int LDS_K=0, LDS_V=NSLOT*SLOTB, LDS_WS=2*NSLOT*SLOTB, LDS_OST=LDS_WS+NW*64*4, LDS_BYTES=LDS_OST+NW*4096;
constexpr float C2=0.125f*1.4426950408889634f;
__device__ __forceinline__ void glds16(const void*gsrc,unsigned lds_dst){unsigned keep;
  asm volatile("s_mov_b32 %0, m0\n\ts_mov_b32 m0, %2\n\ts_nop 0\n\tglobal_load_lds_dwordx4 %1, off\n\ts_mov_b32 m0, %0":"=&s"(keep):"v"(gsrc),"s"(lds_dst):"memory");}
__device__ __forceinline__ float max3f(float a,float b,float c){float r;asm("v_max3_f32 %0, %1, %2, %3":"=v"(r):"v"(a),"v"(b),"v"(c));return r;}
__device__ __forceinline__ float max2f(float a,float b){float r;asm("v_max_f32_e32 %0, %1, %2":"=v"(r):"v"(a),"v"(b));return r;}
__device__ __forceinline__ float fadd_s(float a,float b){float r;asm("v_add_f32_e32 %0, %1, %2":"=v"(r):"v"(a),"v"(b));return r;}
__device__ __forceinline__ float fsub_s(float a,float b){float r;asm("v_sub_f32_e32 %0, %1, %2":"=v"(r):"v"(a),"v"(b));return r;}
typedef float f32x2_t __attribute__((ext_vector_type(2))); typedef __bf16 bf16x2_t __attribute__((ext_vector_type(2)));
__device__ __forceinline__ unsigned cvtpk_s(float lo,float hi){f32x2_t v={lo,hi};bf16x2_t b=__builtin_convertvector(v,bf16x2_t);return __builtin_bit_cast(unsigned,b);}
#define WAIT_BAR(N) asm volatile("s_waitcnt vmcnt(" #N ") lgkmcnt(0)\n\ts_barrier":::"memory")

__device__ __forceinline__ void qkt(f32x16&p0,f32x16&p1,const char*Kslot,const bf16x8*qr,const f32x16&negm,int r32,int hi){
  const char*kb=Kslot+hi*1024+r32*16;
  #pragma unroll
  for(int d0=0;d0<4;++d0){
    const bf16x8 b0=*reinterpret_cast<const bf16x8*>(kb+d0*2048);
    const bf16x8 b1=*reinterpret_cast<const bf16x8*>(kb+d0*2048+512);
    if(d0==0){p0=__builtin_amdgcn_mfma_f32_32x32x16_bf16(b0,qr[0],negm,0,0,0);p1=__builtin_amdgcn_mfma_f32_32x32x16_bf16(b1,qr[0],negm,0,0,0);}
    else{p0=__builtin_amdgcn_mfma_f32_32x32x16_bf16(b0,qr[d0],p0,0,0,0);p1=__builtin_amdgcn_mfma_f32_32x32x16_bf16(b1,qr[d0],p1,0,0,0);}}
}
typedef __attribute__((address_space(3))) const char* lds_cptr;
typedef short v4i16_t __attribute__((ext_vector_type(4)));
__device__ __forceinline__ void kload8(bf16x8*kf,lds_cptr kp){
  kf[0]=*(const __attribute__((address_space(3))) bf16x8*)(kp);      kf[1]=*(const __attribute__((address_space(3))) bf16x8*)(kp+512);
  kf[2]=*(const __attribute__((address_space(3))) bf16x8*)(kp+2048); kf[3]=*(const __attribute__((address_space(3))) bf16x8*)(kp+2560);
  kf[4]=*(const __attribute__((address_space(3))) bf16x8*)(kp+4096); kf[5]=*(const __attribute__((address_space(3))) bf16x8*)(kp+4608);
  kf[6]=*(const __attribute__((address_space(3))) bf16x8*)(kp+6144); kf[7]=*(const __attribute__((address_space(3))) bf16x8*)(kp+6656);
}
__device__ __forceinline__ void kload2(bf16x8*kf,lds_cptr kp,int j){ kf[2*j]=*(const __attribute__((address_space(3))) bf16x8*)(kp+j*2048); kf[2*j+1]=*(const __attribute__((address_space(3))) bf16x8*)(kp+j*2048+512); }
__device__ __forceinline__ s16x4 vtr(lds_cptr p){ return __builtin_bit_cast(s16x4,__builtin_amdgcn_ds_read_tr16_b64_v4i16((__attribute__((address_space(3))) v4i16_t*)p)); }
__device__ __forceinline__ float rowmax(const f32x16&p0,const f32x16&p1){
  float a=max3f(p0[0],p0[1],p1[0]),b=max3f(p0[2],p0[3],p1[1]);a=max3f(a,p1[2],p1[3]);
  #pragma unroll
  for(int r=4;r<16;r+=4){a=max3f(a,p0[r],p0[r+1]);b=max3f(b,p0[r+2],p0[r+3]);a=max3f(a,p1[r],p1[r+1]);b=max3f(b,p1[r+2],p1[r+3]);}
  const float m=max2f(a,b);
  auto rr=__builtin_amdgcn_permlane32_swap(__float_as_uint(m),__float_as_uint(m),false,false);
  return max2f(__uint_as_float(rr[0]),__uint_as_float(rr[1]));
}
__device__ __forceinline__ void pv(f32x16*o,int vb,bf16x8 pa0,bf16x8 pa1,bf16x8 pa2,bf16x8 pa3){
  #pragma unroll
  for(int d0=0;d0<2;++d0){s16x4 lo[4],hi[4];
    #pragma unroll
    for(int ks=0;ks<4;++ks){
      asm volatile("ds_read_b64_tr_b16 %0,%1 offset:%c2":"=&v"(lo[ks]):"v"(vb),"i"(d0*4096+ks*1024):"memory");
      asm volatile("ds_read_b64_tr_b16 %0,%1 offset:%c2":"=&v"(hi[ks]):"v"(vb),"i"(d0*4096+ks*1024+512):"memory");}
    asm volatile("s_waitcnt lgkmcnt(0)":::"memory");SBAR();
    #define PK(k) (bf16x8){lo[k][0],lo[k][1],lo[k][2],lo[k][3],hi[k][0],hi[k][1],hi[k][2],hi[k][3]}
    o[d0]=__builtin_amdgcn_mfma_f32_32x32x16_bf16(pa0,PK(0),o[d0],0,0,0);
    o[d0]=__builtin_amdgcn_mfma_f32_32x32x16_bf16(pa1,PK(1),o[d0],0,0,0);
    o[d0]=__builtin_amdgcn_mfma_f32_32x32x16_bf16(pa2,PK(2),o[d0],0,0,0);
    o[d0]=__builtin_amdgcn_mfma_f32_32x32x16_bf16(pa3,PK(3),o[d0],0,0,0);
    #undef PK
  }
}

#ifndef ATTN_STORE16
#define ATTN_STORE16(p,v) (*(u32x4*)(p)=(v))
#endif
template<int THRL> __device__ __forceinline__ void attn_unit(long rowbase,int NT,int qcol,int kcol,int vcol,int qb,const bf16*Q,const bf16*__restrict__ K,const bf16*__restrict__ V,bf16*O,char*shm){
  const int tid=threadIdx.x,lane=tid&63,r32=lane&31,hi=lane>>5; const int wid=__builtin_amdgcn_readfirstlane(tid>>6);
  const int q0=qb*QB;
  const bf16*Qw=Q+(rowbase+q0+wid*QBLK)*QP+qcol;
  const bf16*Kh=K+rowbase*KVP+kcol,*Vh=V+rowbase*KVP+vcol;
  const unsigned lds0=(unsigned)(uintptr_t)shm;
  float*wsf=(float*)(shm+LDS_WS)+wid*64;
  const bf16*ksrc=Kh+(long)lane*KVP+wid*8;
  const bf16*vsrc=Vh+(long)(16*(wid&3)+(lane>>2))*KVP+(wid>>2)*32+(lane&3)*8;
  const unsigned kdst=lds0+LDS_K+wid*1024, vdst=lds0+LDS_V+wid*1024;
  #define DMA_K(t,slot) glds16(ksrc+(long)(t)*KVBLK*KVP,(unsigned)__builtin_amdgcn_readfirstlane(kdst+(slot)))
  #define DMA_V(t,slot) glds16(vsrc+(long)(t)*KVBLK*KVP,(unsigned)__builtin_amdgcn_readfirstlane(vdst+(slot)))
  const int vb0=(int)(lds0+LDS_V)+((lane>>4)&1)*32+(lane&3)*8+(4*hi+((lane&15)>>2))*64;
  const char*Kbase=shm+LDS_K; bf16x8 kf[8];
  const lds_cptr shm3=(lds_cptr)shm; const lds_cptr kp0=shm3+LDS_K+hi*1024+r32*16; const lds_cptr vp0=shm3+LDS_V+((lane>>4)&1)*32+(lane&3)*8+(4*hi+((lane&15)>>2))*64;
  DMA_K(0,0);DMA_V(0,0);DMA_K(1,SLOTB);
  bf16x8 qr[4];
  #pragma unroll
  for(int d0=0;d0<4;++d0)qr[d0]=*reinterpret_cast<const bf16x8*>(&Qw[(long)r32*QP+d0*16+hi*8]);
  float mhat=0.f,l_reg=0.f;f32x16 o[2];o[0]=f32x16{};o[1]=f32x16{};f32x16 negm=f32x16{};asm volatile("":"+v"(negm));
  #define CMASK(P0,P1,t) do{}while(0)
  bool resc=false;
  #define START(P0,P1) do{ const float rm=rowmax(P0,P1); resc=false; \
    { const float dl=rm; mhat=fadd_s(mhat,dl); \
      _Pragma("unroll") for(int r=0;r<16;++r){P0[r]=fsub_s(P0[r],dl);P1[r]=fsub_s(P1[r],dl);} \
      _Pragma("unroll") for(int r=0;r<16;++r)negm[r]=-mhat; asm volatile("":"+v"(negm)); } \
    _Pragma("unroll") for(int r=0;r<16;++r)P0[r]=__builtin_amdgcn_exp2f(P0[r]); }while(0)
  #define RESC() do{ if(resc){ asm volatile("s_waitcnt lgkmcnt(0)":::"memory"); \
      _Pragma("unroll") for(int d_=0;d_<2;++d_) _Pragma("unroll") for(int r=0;r<16;++r)o[d_][r]*=wsf[crow(r,hi)]; } }while(0)
  f32x16 pA0,pA1,pB0,pB1;
  int sl_prev=0,sl_cur=0,sl_next=SLOTB;
  #define ROT() do{sl_prev=sl_cur;sl_cur=sl_next;sl_next=(sl_next==(NSLOT-1)*SLOTB)?0:sl_next+SLOTB;}while(0)
  DMA_K(2,2*SLOTB);
  WAIT_BAR(3);
  qkt(pA0,pA1,Kbase,qr,negm,r32,hi);asm volatile("s_nop 15\n\ts_nop 7":"+v"(pA0),"+v"(pA1));CMASK(pA0,pA1,0);
  START(pA0,pA1);
  _Pragma("unroll") for(int r=0;r<16;++r)pA1[r]=__builtin_amdgcn_exp2f(pA1[r]);
  WAIT_BAR(0);
  DMA_K(3,0);DMA_V(1,SLOTB);
  ROT();
  kload8(kf,kp0+sl_cur);
  WAIT_BAR(2);
  s16x4 vlo[8],vhi[8]; u32x4 pw0,pw1,pw2,pw3;
  #define PKW(P,B) cvtpk_s(P[B],P[B+1])
  #define PAF(k) __builtin_bit_cast(bf16x8,pw##k)
  #define VFR(i) (bf16x8){vlo[i][0],vlo[i][1],vlo[i][2],vlo[i][3],vhi[i][0],vhi[i][1],vhi[i][2],vhi[i][3]}
  #define PIN(x) asm volatile("":"+v"(x))
  #define MX3(a,b,c) __builtin_fmaxf(__builtin_fmaxf((a),(b)),(c))
  #define GAPA(MF,A0,A1,A2,A3,W0,W1,PW) do{ MF; sacc+=A0; sacc+=A1; sacc+=A2; sacc+=A3; PIN(sacc); W0; W1; PIN(PW); SBAR(); }while(0)
  #define EX(v) __builtin_amdgcn_exp2f(v)
  #define GAPB(MF,X,B) do{ MF; X[B]=EX(X[B]); X[B+1]=EX(X[B+1]); X[B+2]=EX(X[B+2]); X[B+3]=EX(X[B+3]); PIN(X); SBAR(); }while(0)
  #define VRD(i) do{ vlo[i]=vtr(vp_+(((i)>>2)*4096+((i)&3)*1024)); vhi[i]=vtr(vp_+(((i)>>2)*4096+((i)&3)*1024+512)); }while(0)
  #define KRD(G,j) do{ if(G){ kload2(kf,kp0+sl_next,j); SBAR(); } }while(0)
  #define STEP(C0,C1,P0,P1,t,GK,GV,GL) do{ SBAR(); \
    const lds_cptr vp_=vp0+sl_prev; \
    VRD(0); SBAR(); float sacc=(P0[0]+P0[1]); \
    GAPA(C0=__builtin_amdgcn_mfma_f32_32x32x16_bf16(kf[0],qr[0],negm,0,0,0), P0[2],P0[3],P0[4],P0[5],     pw0[0]=PKW(P0,0), pw0[1]=PKW(P0,2), pw0); \
    VRD(4); SBAR(); GAPA(C1=__builtin_amdgcn_mfma_f32_32x32x16_bf16(kf[1],qr[0],negm,0,0,0), P0[6],P0[7],P0[8],P0[9],     pw0[2]=PKW(P0,4), pw0[3]=PKW(P0,6), pw0); \
    VRD(1); SBAR(); GAPA(C0=__builtin_amdgcn_mfma_f32_32x32x16_bf16(kf[2],qr[1],C0,0,0,0),   P0[10],P0[11],P0[12],P0[13], pw1[0]=PKW(P0,8), pw1[1]=PKW(P0,10), pw1); \
    VRD(5); SBAR(); GAPA(C1=__builtin_amdgcn_mfma_f32_32x32x16_bf16(kf[3],qr[1],C1,0,0,0),   P0[14],P0[15],P1[0],P1[1],   pw1[2]=PKW(P0,12),pw1[3]=PKW(P0,14), pw1); \
    VRD(2); SBAR(); GAPA(C0=__builtin_amdgcn_mfma_f32_32x32x16_bf16(kf[4],qr[2],C0,0,0,0),   P1[2],P1[3],P1[4],P1[5],     pw2[0]=PKW(P1,0), pw2[1]=PKW(P1,2), pw2); \
    VRD(6); SBAR(); GAPA(C1=__builtin_amdgcn_mfma_f32_32x32x16_bf16(kf[5],qr[2],C1,0,0,0),   P1[6],P1[7],P1[8],P1[9],     pw2[2]=PKW(P1,4), pw2[3]=PKW(P1,6), pw2); \
    VRD(3); SBAR(); GAPA(C0=__builtin_amdgcn_mfma_f32_32x32x16_bf16(kf[6],qr[3],C0,0,0,0),   P1[10],P1[11],P1[12],P1[13], pw3[0]=PKW(P1,8), pw3[1]=PKW(P1,10), pw3); \
    VRD(7); SBAR(); GAPA(C1=__builtin_amdgcn_mfma_f32_32x32x16_bf16(kf[7],qr[3],C1,0,0,0),   P1[14],P1[15],0.f,0.f,       pw3[2]=PKW(P1,12),pw3[3]=PKW(P1,14), pw3); \
    l_reg+=sacc; \
    if(GK){DMA_K((t)+3,sl_cur);} if(GV){DMA_V((t)+1,sl_next);} \
    CMASK(C0,C1,t); \
    { float a=MX3(C0[0],C0[1],C1[0]),b=MX3(C0[2],C0[3],C1[1]); a=MX3(a,C1[2],C1[3]); \
      _Pragma("unroll") for(int r=4;r<16;r+=4){a=MX3(a,C0[r],C0[r+1]);b=MX3(b,C0[r+2],C0[r+3]);a=MX3(a,C1[r],C1[r+1]);b=MX3(b,C1[r+2],C1[r+3]);} \
      float rm=__builtin_fmaxf(a,b); { auto rr=__builtin_amdgcn_permlane32_swap(__float_as_uint(rm),__float_as_uint(rm),false,false); rm=__builtin_fmaxf(__uint_as_float(rr[0]),__uint_as_float(rr[1])); } \
      resc=false; \
      if(__builtin_expect(__any(rm>(float)THRL),0)){ const float dl=__builtin_fmaxf(rm,0.f); mhat+=dl; \
        _Pragma("unroll") for(int r=0;r<16;++r){C0[r]-=dl;C1[r]-=dl;} \
        _Pragma("unroll") for(int r=0;r<16;++r)negm[r]=-mhat; asm volatile("":"+v"(negm)); \
        const float f=__builtin_amdgcn_exp2f(-dl); l_reg*=f; if(hi==0)wsf[r32]=f; resc=true; } } \
    SBAR(); \
    GAPB(o[0]=__builtin_amdgcn_mfma_f32_32x32x16_bf16(PAF(0),VFR(0),o[0],0,0,0), C0,0); \
    GAPB(o[1]=__builtin_amdgcn_mfma_f32_32x32x16_bf16(PAF(0),VFR(4),o[1],0,0,0), C0,4); \
    KRD(GL,0); GAPB(o[0]=__builtin_amdgcn_mfma_f32_32x32x16_bf16(PAF(1),VFR(1),o[0],0,0,0), C0,8); \
    KRD(GL,1); GAPB(o[1]=__builtin_amdgcn_mfma_f32_32x32x16_bf16(PAF(1),VFR(5),o[1],0,0,0), C0,12); \
    KRD(GL,2); GAPB(o[0]=__builtin_amdgcn_mfma_f32_32x32x16_bf16(PAF(2),VFR(2),o[0],0,0,0), C1,0); \
    KRD(GL,3); GAPB(o[1]=__builtin_amdgcn_mfma_f32_32x32x16_bf16(PAF(2),VFR(6),o[1],0,0,0), C1,4); \
    GAPB(o[0]=__builtin_amdgcn_mfma_f32_32x32x16_bf16(PAF(3),VFR(3),o[0],0,0,0), C1,8); \
    GAPB(o[1]=__builtin_amdgcn_mfma_f32_32x32x16_bf16(PAF(3),VFR(7),o[1],0,0,0), C1,12); \
    }while(0)
  int t=1;
  #undef CMASK
  #define CMASK(P0,P1,t) do{}while(0)
  for(;t+5<NT;t+=2){
    STEP(pB0,pB1,pA0,pA1,t,true,true,true);     WAIT_BAR(2); RESC(); ROT();
    STEP(pA0,pA1,pB0,pB1,t+1,true,true,true);   WAIT_BAR(2); RESC(); ROT();
  }
  #undef CMASK
  #define CMASK(P0,P1,t) do{}while(0)
  #define ENDW(tt) do{ if((tt)+3<NT){WAIT_BAR(2);} else if((tt)+2<NT){WAIT_BAR(1);} else {WAIT_BAR(0);} }while(0)
  for(;t+1<NT;t+=2){
    STEP(pB0,pB1,pA0,pA1,t,(t+3<NT),(t+1<NT),(t+1<NT));       ENDW(t);   RESC(); ROT();
    STEP(pA0,pA1,pB0,pB1,t+1,(t+4<NT),(t+2<NT),(t+2<NT));     ENDW(t+1); RESC(); ROT();
  }
  STEP(pB0,pB1,pA0,pA1,NT-1,false,false,false); RESC();
  { float sacc=pB0[0]+pB0[1]; _Pragma("unroll") for(int r=2;r<16;++r)sacc+=pB0[r]; _Pragma("unroll") for(int r=0;r<16;++r)sacc+=pB1[r]; l_reg+=sacc;
    pw0=(u32x4){PKW(pB0,0),PKW(pB0,2),PKW(pB0,4),PKW(pB0,6)};pw1=(u32x4){PKW(pB0,8),PKW(pB0,10),PKW(pB0,12),PKW(pB0,14)};pw2=(u32x4){PKW(pB1,0),PKW(pB1,2),PKW(pB1,4),PKW(pB1,6)};pw3=(u32x4){PKW(pB1,8),PKW(pB1,10),PKW(pB1,12),PKW(pB1,14)};
    SBAR(); pv(o,vb0+sl_cur,PAF(0),PAF(1),PAF(2),PAF(3)); }
  #undef PKW
  #undef PAF
  #undef VFR
  #undef PIN
  #undef MX3
  #undef GAPA
  #undef GAPB
  #undef EX
  #undef VRD
  #undef KRD
  #undef STEP
  #undef ENDW
  {auto rr=__builtin_amdgcn_permlane32_swap(__float_as_uint(l_reg),__float_as_uint(l_reg),false,false);l_reg=__uint_as_float(rr[0])+__uint_as_float(rr[1]);}
  if(hi==0)wsf[32+r32]=l_reg;asm volatile("s_waitcnt lgkmcnt(0)":::"memory");
  float rli[16];
  #pragma unroll
  for(int r=0;r<16;++r)rli[r]=__builtin_amdgcn_rcpf(wsf[32+crow(r,hi)]);
  bf16*Ow=O+(rowbase+q0+wid*QBLK)*QP+qcol;
  { bf16*stg=(bf16*)(shm+LDS_OST)+wid*2048;
    #pragma unroll
    for(int r=0;r<16;++r){const int orow=crow(r,hi);
      #pragma unroll
      for(int d0=0;d0<2;++d0)stg[orow*64+d0*32+r32]=__float2bfloat16(o[d0][r]*rli[r]);}
    asm volatile("s_waitcnt lgkmcnt(0)":::"memory");
    #pragma unroll
    for(int i=0;i<4;++i){const int row=i*8+(lane>>3),ch=lane&7; const u32x4 v=*(const u32x4*)(stg+row*64+ch*8); ATTN_STORE16(Ow+(long)row*QP+ch*8,v);} }
  asm volatile("s_waitcnt lgkmcnt(0)\n\ts_barrier":::"memory");
  #undef DMA_K
  #undef DMA_V
  #undef CMASK
  #undef START
  #undef RESC
  #undef ROT
}
constexpr int ATTN_LDS_BYTES=LDS_BYTES;

struct AttnUnit { long rowbase; int NT, h, qb; };
struct UnitOrder {
  int vcu, G;
  __device__ __forceinline__ UnitOrder(int grid,int v):vcu(v),G(grid){}
  __device__ __forceinline__ bool next(int i,AttnUnit&u)const{
    const int v=vcu+(i/6)*G, j=i%6; if(v>=256)return false;
    if(j<2){ const int pu=2*v+j; u.rowbase=0; u.NT=256; u.h=pu>>6; u.qb=pu&63; }
    else { const int su=4*v+(j-2); u.rowbase=16384+(long)(su>>6)*2048; u.NT=32; u.h=(su>>3)&7; u.qb=su&7; }
    return true; }
};
template<int THRL=8> __device__ __forceinline__ void attn_phase(char*lds,const bf16*MIXQ,const bf16*KV,bf16*MIXO,const UnitOrder&S){
  AttnUnit u;
  for(int i=0;S.next(i,u);++i){ attn_unit<THRL>(u.rowbase,u.NT,512+u.h*64,(u.h>>2)*64,128+(u.h>>2)*64,u.qb,MIXQ,KV,KV,MIXO,lds); }
}
namespace mls {
constexpr int SC=256, ST_STRIDE=4176, NITEM=192*8;
constexpr int ML_K=0, ML_V=32768, ML_ARR=65536, ML_CF=73728, ML_CB=82944, ML_N=92160, ML_SCAL=92672, ML_WS=93184, ML_STG=95232, ML_END=128000;
constexpr int CROWB=144;
constexpr float L2E=1.4426950408889634f, MEPS=1e-6f;
typedef float f32x4m __attribute__((ext_vector_type(4)));
__device__ __forceinline__ float blo(unsigned w){return __builtin_bit_cast(float,w<<16);}
__device__ __forceinline__ float bhi(unsigned w){return __builtin_bit_cast(float,w&0xffff0000u);}
__device__ __forceinline__ float sbf(short v){return __builtin_bit_cast(float,((unsigned)(unsigned short)v)<<16);}
__device__ __forceinline__ float logsig(float x){ return x<0.f ? x-log1pf(__expf(x)) : -log1pf(__expf(-x)); }
__device__ __forceinline__ float scan_sum(float v,int lane){
  #pragma unroll
  for(int o=1;o<64;o<<=1){ const float t=__shfl_up(v,o); if(lane>=o) v+=t; } return v; }
__device__ __forceinline__ float scan_max(float v,int lane){
  #pragma unroll
  for(int o=1;o<64;o<<=1){ const float t=__shfl_up(v,o); if(lane>=o) v=fmaxf(v,t); } return v; }
__device__ __forceinline__ float rscan_max(float v,int lane){
  #pragma unroll
  for(int o=1;o<64;o<<=1){ const float t=__shfl_down(v,o); if(lane+o<64) v=fmaxf(v,t); } return v; }
__device__ __forceinline__ float wmaxf(float v){
  #pragma unroll
  for(int o=1;o<64;o<<=1) v=fmaxf(v,__shfl_xor(v,o));
  return v; }
template<int MODE> __device__ __forceinline__ void gate_setup(const float*GT,long row0,int h,const float*st,char*shm,int lane){
  float*ARR=(float*)(shm+ML_ARR); float*SCAL=(float*)(shm+ML_SCAL);
  float i_f[4],i_b[4],lf[4],lb[4];
  #pragma unroll
  for(int k=0;k<4;++k){ const float*g=GT+(row0+4*lane+k)*32; i_f[k]=g[h]; i_b[k]=g[8+h]; lf[k]=logsig(g[16+h]); lb[k]=logsig(g[24+h]); }
  float pf[4],pb[4]; pf[0]=lf[0]; pb[0]=lb[0];
  #pragma unroll
  for(int k=1;k<4;++k){ pf[k]=pf[k-1]+lf[k]; pb[k]=pb[k-1]+lb[k]; }
  const float inF=scan_sum(pf[3],lane), inB=scan_sum(pb[3],lane); const float offF=inF-pf[3], offB=inB-pb[3];
  const float totF=__shfl(inF,63), totB=__shfl(inB,63);
  float P[4],R[4];
  #pragma unroll
  for(int k=0;k<4;++k){ P[k]=offF+pf[k]; R[k]=totB-(offB+pb[k])+lb[k]; }
  if(MODE==1){
    float wF[4],wB[4]; float mxF=-INFINITY,mxB=-INFINITY;
    #pragma unroll
    for(int k=0;k<4;++k){ wF[k]=totF-P[k]+i_f[k]; wB[k]=(totB-R[k])+i_b[k]; mxF=fmaxf(mxF,wF[k]); mxB=fmaxf(mxB,wB[k]); }
    const float aF=wmaxf(mxF), aB=wmaxf(mxB);
    #pragma unroll
    for(int k=0;k<4;++k){ ARR[4*lane+k]=__expf(wF[k]-aF); ARR[256+4*lane+k]=__expf(wB[k]-aB); }
    if(lane==0){ SCAL[0]=aF; SCAL[1]=totF; SCAL[2]=aB; SCAL[3]=totB; }
  } else {
    const float mFp=st[4162], mBp=st[ST_STRIDE+4162];
    float gF[4],gB[4],pm[4],sm[4];
    #pragma unroll
    for(int k=0;k<4;++k){ gF[k]=i_f[k]-P[k]; gB[k]=i_b[k]-R[k]; }
    pm[0]=gF[0]; sm[3]=gB[3];
    #pragma unroll
    for(int k=1;k<4;++k){ pm[k]=fmaxf(pm[k-1],gF[k]); sm[3-k]=fmaxf(sm[4-k],gB[3-k]); }
    const float inc=scan_max(pm[3],lane); float exc=__shfl_up(inc,1); if(lane==0)exc=-INFINITY;
    const float incr=rscan_max(sm[0],lane); float excr=__shfl_down(incr,1); if(lane==63)excr=-INFINITY;
    #pragma unroll
    for(int k=0;k<4;++k){ const int s=4*lane+k; const float muF=fmaxf(mFp,fmaxf(exc,pm[k])), muB=fmaxf(mBp,fmaxf(excr,sm[k]));
      ARR[s]=gF[k]*L2E; ARR[256+s]=gB[k]*L2E; ARR[512+s]=muF*L2E; ARR[768+s]=muB*L2E; ARR[1024+s]=__expf(mFp-muF); ARR[1280+s]=__expf(mBp-muB);
      ARR[1536+s]=__expf(-(P[k]+muF)); ARR[1792+s]=__expf(-(R[k]+muB)); }
  }
}
__device__ __forceinline__ void load_kv(const bf16*Kh,const bf16*Vh,unsigned lds0,int wid,int lane){
  #pragma unroll
  for(int t=0;t<4;++t){
    glds16(Kh+(long)(t*64+lane)*512+wid*8,(unsigned)__builtin_amdgcn_readfirstlane(lds0+ML_K+t*8192+wid*1024));
    glds16(Vh+(long)(t*64+16*(wid&3)+(lane>>2))*512+(wid>>2)*32+(lane&3)*8,(unsigned)__builtin_amdgcn_readfirstlane(lds0+ML_V+t*8192+wid*1024)); }
}
__device__ __forceinline__ void m1_item(int item,const bf16*MK,const bf16*MV,const float*GT,float*STATE,char*shm){
  const int tid=threadIdx.x,lane=tid&63,r32=lane&31,hi=lane>>5; const int wid=__builtin_amdgcn_readfirstlane(tid>>6);
  const int scg=item>>3,h=item&7; const long row0=(long)scg*SC;
  const unsigned lds0=(unsigned)(uintptr_t)shm;
  load_kv(MK+row0*512+h*64,MV+row0*512+h*64,lds0,wid,lane);
  float*st=STATE+(size_t)item*2*ST_STRIDE;
  if(wid==0) gate_setup<1>(GT,row0,h,st,shm,lane);
  asm volatile("s_waitcnt vmcnt(0) lgkmcnt(0)":::"memory"); __syncthreads();
  const float*ARR=(const float*)(shm+ML_ARR);
  const int dir=wid>>2, mt=(wid>>1)&1, nt=wid&1;
  const float*we=ARR+dir*256;
  f32x16 acc=f32x16{};
  const lds_cptr shm3=(lds_cptr)shm;
  const lds_cptr vp0=shm3+ML_V+mt*4096+((lane>>4)&1)*32+(lane&3)*8+(4*hi+((lane&15)>>2))*64;
  const int kcol=32*nt+16*((lane>>4)&1)+4*(lane&3);
  const lds_cptr kp0=shm3+ML_K+(kcol>>3)*1024+(4*hi+((lane&15)>>2))*16+(kcol&7)*2;
  #pragma unroll
  for(int t=0;t<4;++t){
    #pragma unroll
    for(int ks=0;ks<4;++ks){
      const s16x4 alo=vtr(vp0+t*8192+ks*1024), ahi=vtr(vp0+t*8192+ks*1024+512);
      const s16x4 klo=vtr(kp0+t*8192+ks*256), khi=vtr(kp0+t*8192+ks*256+128);
      const f32x4m w0=*(const f32x4m*)(we+64*t+16*ks+4*hi), w1=*(const f32x4m*)(we+64*t+16*ks+8+4*hi);
      u32x4 aw; aw[0]=cvtpk_s(sbf(alo[0])*w0[0],sbf(alo[1])*w0[1]); aw[1]=cvtpk_s(sbf(alo[2])*w0[2],sbf(alo[3])*w0[3]);
      aw[2]=cvtpk_s(sbf(ahi[0])*w1[0],sbf(ahi[1])*w1[1]); aw[3]=cvtpk_s(sbf(ahi[2])*w1[2],sbf(ahi[3])*w1[3]);
      const bf16x8 Bf=(bf16x8){klo[0],klo[1],klo[2],klo[3],khi[0],khi[1],khi[2],khi[3]};
      acc=__builtin_amdgcn_mfma_f32_32x32x16_bf16(__builtin_bit_cast(bf16x8,aw),Bf,acc,0,0,0); } }
  float*cst=st+(size_t)dir*ST_STRIDE;
  #pragma unroll
  for(int r=0;r<16;++r) cst[(32*mt+crow(r,hi))*64+32*nt+r32]=acc[r];
  if(tid<128){ const int d=tid>>6, dk=tid&63; const float*wv=ARR+d*256; float s=0.f;
    const unsigned short*kimg=(const unsigned short*)(shm+ML_K+(dk>>3)*1024+(dk&7)*2);
    for(int t=0;t<4;++t) for(int kl=0;kl<64;++kl) s+=wv[64*t+kl]*__builtin_bit_cast(float,((unsigned)kimg[t*4096+kl*8])<<16);
    st[(size_t)d*ST_STRIDE+4096+dk]=s; }
  if(tid==0){ const float*SCAL=(const float*)(shm+ML_SCAL); st[4160]=SCAL[0]; st[4161]=SCAL[1]; st[ST_STRIDE+4160]=SCAL[2]; st[ST_STRIDE+4161]=SCAL[3]; }
  __syncthreads();
}
__device__ __forceinline__ void m2_scan(float*STATE,int gt,int NTH){
  constexpr int NV=1040, NP=16*NV, NS=16*16*NV;
  for(int ti=gt;ti<NP+NS;ti+=NTH){
    int seq,r; if(ti<NP){seq=0;r=ti;} else { const int r2=ti-NP; seq=1+r2/NP; r=r2%NP; }
    const int hd=r/NV, e=r%NV, h=hd>>1, dir=hd&1;
    const int nsc=seq==0?64:8, sc0=seq==0?0:64+(seq-1)*8;
    f32x4m state=(f32x4m){0.f,0.f,0.f,0.f}; float m=0.f;
    for(int s0=0;s0<nsc;s0+=8){
      f32x4m loc[8]; float av[8],bl[8];
      #pragma unroll
      for(int j=0;j<8;++j){ const int step=s0+j, c=dir?nsc-1-step:step; float*base=STATE+((size_t)((sc0+c)*8+h)*2+dir)*ST_STRIDE;
        loc[j]=*(const f32x4m*)(base+4*e); av[j]=base[4160]; bl[j]=base[4161]; }
      #pragma unroll
      for(int j=0;j<8;++j){ const int step=s0+j, c=dir?nsc-1-step:step; float*base=STATE+((size_t)((sc0+c)*8+h)*2+dir)*ST_STRIDE;
        *(f32x4m*)(base+4*e)=state; if(e==0) base[4162]=m;
        const float mn=fmaxf(bl[j]+m,av[j]), dec=__expf(bl[j]+m-mn), wl=__expf(av[j]-mn);
        state=state*dec+loc[j]*wl; m=mn; }
    }
  }
}
__device__ __forceinline__ void m3_item(int item,const bf16*Q,const bf16*MK,const bf16*MV,const bf16*MO,const float*GT,const float*STATE,const float*mhw,bf16*OUT,char*shm){
  const int tid=threadIdx.x,lane=tid&63,r32=lane&31,hi=lane>>5; const int wid=__builtin_amdgcn_readfirstlane(tid>>6);
  const int scg=item>>3,h=item&7; const long row0=(long)scg*SC;
  const unsigned lds0=(unsigned)(uintptr_t)shm;
  load_kv(MK+row0*512+h*64,MV+row0*512+h*64,lds0,wid,lane);
  const float*st=STATE+(size_t)item*2*ST_STRIDE;
  { const int dv=tid>>3,c8=tid&7;
    #pragma unroll
    for(int d=0;d<2;++d){ const f32x4m a=*(const f32x4m*)(st+(size_t)d*ST_STRIDE+dv*64+c8*8), b=*(const f32x4m*)(st+(size_t)d*ST_STRIDE+dv*64+c8*8+4);
      u32x4 w; w[0]=cvtpk_s(a[0],a[1]); w[1]=cvtpk_s(a[2],a[3]); w[2]=cvtpk_s(b[0],b[1]); w[3]=cvtpk_s(b[2],b[3]);
      *(u32x4*)(shm+(d?ML_CB:ML_CF)+dv*CROWB+c8*16)=w; } }
  if(tid<128) ((float*)(shm+ML_N))[tid]=st[(size_t)(tid>>6)*ST_STRIDE+4096+(tid&63)];
  if(wid==0) gate_setup<3>(GT,row0,h,st,shm,lane);
  asm volatile("s_waitcnt vmcnt(0) lgkmcnt(0)":::"memory"); __syncthreads();
  const float*ARR=(const float*)(shm+ML_ARR);
  const int l=32*wid+r32; const long qrow=row0+l;
  bf16x8 qr[4];
  #pragma unroll
  for(int ks=0;ks<4;++ks) qr[ks]=*reinterpret_cast<const bf16x8*>(&Q[qrow*1024+h*64+ks*16+hi*8]);
  const float muF=ARR[512+l], muB=ARR[768+l], iwF=ARR[1024+l], iwB=ARR[1280+l], flF=ARR[1536+l], flB=ARR[1792+l];
  const float*nF=(const float*)(shm+ML_N); const float*nB=nF+64;
  float qnF=0.f,qnB=0.f;
  f32x16 oF[2],oB[2]; oF[0]=f32x16{}; oF[1]=f32x16{}; oB[0]=f32x16{}; oB[1]=f32x16{};
  #pragma unroll
  for(int ks=0;ks<4;++ks){ float x[8];
    #pragma unroll
    for(int j=0;j<8;++j) x[j]=sbf(qr[ks][j]);
    #pragma unroll
    for(int j=0;j<8;++j){ qnF+=x[j]*nF[16*ks+8*hi+j]; qnB+=x[j]*nB[16*ks+8*hi+j]; }
    { u32x4 wf;
      #pragma unroll
      for(int j=0;j<4;++j) wf[j]=cvtpk_s(x[2*j]*iwF,x[2*j+1]*iwF);
      #pragma unroll
      for(int nt=0;nt<2;++nt){ const bf16x8 bF=*reinterpret_cast<const bf16x8*>(shm+ML_CF+(32*nt+r32)*CROWB+(16*ks+8*hi)*2);
        oF[nt]=__builtin_amdgcn_mfma_f32_32x32x16_bf16(__builtin_bit_cast(bf16x8,wf),bF,oF[nt],0,0,0); } }
    { u32x4 wb;
      #pragma unroll
      for(int j=0;j<4;++j) wb[j]=cvtpk_s(x[2*j]*iwB,x[2*j+1]*iwB);
      #pragma unroll
      for(int nt=0;nt<2;++nt){ const bf16x8 bB=*reinterpret_cast<const bf16x8*>(shm+ML_CB+(32*nt+r32)*CROWB+(16*ks+8*hi)*2);
        oB[nt]=__builtin_amdgcn_mfma_f32_32x32x16_bf16(__builtin_bit_cast(bf16x8,wb),bB,oB[nt],0,0,0); } } }
  qnF+=__shfl_xor(qnF,32); qnB+=__shfl_xor(qnB,32);
  float denF=0.f,denB=0.f;
  const int vb0=(int)(lds0+ML_V)+((lane>>4)&1)*32+(lane&3)*8+(4*hi+((lane&15)>>2))*64;
  const char*Kbase=shm+ML_K;
  const int dt=wid>>1;
  #pragma unroll 1
  for(int kt=0;kt<4;++kt){
    f32x16 p0,p1; const f32x16 z=f32x16{};
    qkt(p0,p1,Kbase+kt*8192,qr,z,r32,hi);
    if(kt<=dt){
      const float*g=ARR+64*kt; u32x4 w0,w1,w2,w3;
      #pragma unroll
      for(int j=0;j<8;++j){ float a0[2],a1[2];
        #pragma unroll
        for(int e=0;e<2;++e){ const int r=2*j+e, k0=crow(r,hi), key0=64*kt+k0;
          a0[e]=p0[r]*__builtin_amdgcn_exp2f(fminf(g[k0]-muF,0.f)); a1[e]=p1[r]*__builtin_amdgcn_exp2f(fminf(g[k0+32]-muF,0.f));
          if(kt==dt){ if(key0>l)a0[e]=0.f; if(key0+32>l)a1[e]=0.f; }
          denF+=a0[e]+a1[e]; }
        const unsigned c0=cvtpk_s(a0[0],a0[1]), c1=cvtpk_s(a1[0],a1[1]);
        if(j<4){ w0[j]=c0; w2[j]=c1; } else { w1[j-4]=c0; w3[j-4]=c1; } }
      pv(oF,vb0+kt*8192,__builtin_bit_cast(bf16x8,w0),__builtin_bit_cast(bf16x8,w1),__builtin_bit_cast(bf16x8,w2),__builtin_bit_cast(bf16x8,w3)); }
    if(kt>=dt){
      const float*g=ARR+256+64*kt; u32x4 w0,w1,w2,w3;
      #pragma unroll
      for(int j=0;j<8;++j){ float a0[2],a1[2];
        #pragma unroll
        for(int e=0;e<2;++e){ const int r=2*j+e, k0=crow(r,hi), key0=64*kt+k0;
          a0[e]=p0[r]*__builtin_amdgcn_exp2f(fminf(g[k0]-muB,0.f)); a1[e]=p1[r]*__builtin_amdgcn_exp2f(fminf(g[k0+32]-muB,0.f));
          if(kt==dt){ if(key0<l)a0[e]=0.f; if(key0+32<l)a1[e]=0.f; }
          denB+=a0[e]+a1[e]; }
        const unsigned c0=cvtpk_s(a0[0],a0[1]), c1=cvtpk_s(a1[0],a1[1]);
        if(j<4){ w0[j]=c0; w2[j]=c1; } else { w1[j-4]=c0; w3[j-4]=c1; } }
      pv(oB,vb0+kt*8192,__builtin_bit_cast(bf16x8,w0),__builtin_bit_cast(bf16x8,w1),__builtin_bit_cast(bf16x8,w2),__builtin_bit_cast(bf16x8,w3)); }
  }
  denF+=__shfl_xor(denF,32); denB+=__shfl_xor(denB,32);
  const float rF=1.f/fmaxf(fabsf(denF+iwF*qnF),flF), rB=1.f/fmaxf(fabsf(denB+iwB*qnB),flB);
  float*wsf=(float*)(shm+ML_WS)+wid*64;
  if(hi==0){ wsf[r32]=rF; wsf[32+r32]=rB; }
  asm volatile("s_waitcnt lgkmcnt(0)":::"memory");
  const float mw0=mhw[h*64+r32], mw1=mhw[h*64+32+r32];
  bf16*stg=(bf16*)(shm+ML_STG)+wid*2048;
  #pragma unroll
  for(int r=0;r<16;++r){ const int orow=crow(r,hi); const float sF=wsf[orow], sB=wsf[32+orow];
    const float h0=oF[0][r]*sF+oB[0][r]*sB, h1=oF[1][r]*sF+oB[1][r]*sB;
    float ss=h0*h0+h1*h1;
    ss+=__shfl_xor(ss,1); ss+=__shfl_xor(ss,2); ss+=__shfl_xor(ss,4); ss+=__shfl_xor(ss,8); ss+=__shfl_xor(ss,16);
    const float rstd=1.f/sqrtf(ss*(1.f/64.f)+MEPS);
    stg[orow*64+r32]=__float2bfloat16(h0*rstd*mw0); stg[orow*64+32+r32]=__float2bfloat16(h1*rstd*mw1); }
  asm volatile("s_waitcnt lgkmcnt(0)":::"memory");
  #pragma unroll
  for(int i=0;i<4;++i){ int row=i*8+(lane>>3); const int ch=lane&7; asm volatile("":"+v"(row));
    const u32x4 v=*(const u32x4*)(stg+row*64+ch*8);
    const long grow=row0+32*wid+row; const u32x4 mo=*(const u32x4*)(MO+grow*512+h*64+ch*8); u32x4 o;
    #pragma unroll
    for(int j=0;j<4;++j){ const float y0=blo(v[j])*__builtin_amdgcn_rcpf(1.f+__expf(-blo(mo[j]))), y1=bhi(v[j])*__builtin_amdgcn_rcpf(1.f+__expf(-bhi(mo[j]))); o[j]=cvtpk_s(y0,y1); }
    *(u32x4*)(OUT+grow*1024+h*64+ch*8)=o; }
  __syncthreads();
}
}
#undef SBAR
#undef WAIT_BAR
}


constexpr int NWAVES = 8;
constexpr int DM = 1024, T0 = 16384, NSEQ1 = 16, T1 = 2048, M = T0 + NSEQ1 * T1;
constexpr int HD = 64, NH = 8, MW = 512, INC = 2848, INP = 3072, FF = 2816, FF2 = 5632;
constexpr float EPS = 1e-6f;
static_assert(M == 49152 && M % 256 == 0 && pg8::T0_ROWS == T0, "shapes");

constexpr size_t MiB = 1u << 20;
constexpr size_t WS_CTL = 0, CTL_ZERO_BYTES = 1 * MiB;
constexpr size_t WS_WIN = 2 * MiB, WS_WOUT = 8 * MiB, WS_WUP = 10 * MiB, WS_WDN = 21 * MiB;
constexpr size_t WS_ROPE = 27 * MiB;
constexpr size_t WS_PART1 = 28 * MiB, WS_PART2 = 31 * MiB;
constexpr size_t WS_G = 34 * MiB;
constexpr size_t WS_KV = 40 * MiB;
constexpr size_t WS_XN = 64 * MiB;
constexpr size_t WS_MIX = 160 * MiB;
constexpr size_t WS_MK = 256 * MiB, WS_MV = 304 * MiB, WS_MO = 352 * MiB;
constexpr size_t WS_HF = 400 * MiB;
constexpr size_t WS_ACT = 160 * MiB, WS_HALO = 430 * MiB;
constexpr size_t WS_END = 496 * MiB;
constexpr int CW_BAR = 4096;

constexpr int RING_OFF = 0, RING_BYTES = 131072;
constexpr int LDSCTL_OFF = RING_BYTES, MISC_OFF = LDSCTL_OFF + 320;
constexpr int EX_OFF = RING_BYTES + 1024;
constexpr int LDS_BYTES = 147456;
static_assert(EX_OFF + 8192 <= LDS_BYTES, "LDS map");

#define GAS __attribute__((address_space(1)))
#define LAS __attribute__((address_space(3)))
typedef unsigned short bf16;
typedef unsigned v4u __attribute__((ext_vector_type(4)));
typedef float f32x4 __attribute__((ext_vector_type(4)));
typedef GAS unsigned gu32;
#define RLX_AGENT __ATOMIC_RELAXED, __HIP_MEMORY_SCOPE_AGENT
#define LDS_WAIT() asm volatile("s_waitcnt lgkmcnt(0)" ::: "memory")
#define VM_WAIT() asm volatile("s_waitcnt vmcnt(0)" ::: "memory")
__device__ __forceinline__ unsigned f2bf(float f) { unsigned u = __builtin_bit_cast(unsigned, f); return (u + 0x7fffu + ((u >> 16) & 1u)) >> 16; }
__device__ __forceinline__ unsigned pk2(float lo, float hi) { return f2bf(lo) | (f2bf(hi) << 16); }
__device__ __forceinline__ float bf2f(unsigned short b) { return __builtin_bit_cast(float, (unsigned)b << 16); }
__device__ __forceinline__ float bflo(unsigned w) { return __builtin_bit_cast(float, w << 16); }
__device__ __forceinline__ float bfhi(unsigned w) { return __builtin_bit_cast(float, w & 0xffff0000u); }
#define XB_TMO      128
#define XB_XCNT(j)  (256  + 64 * (j))
#define XB_XSUB(j)  (1280 + 64 * (j))
#define XB_XGEN(j)  (2304 + 64 * (j))
#define XB_TOP      3328
#define XB_TOPGEN   3392
#define XCD_BAR_WORDS 3456
#define XB_SPIN_CAP (1u << 24)

__device__ __forceinline__ unsigned xb_ld(unsigned* p)              { return __hip_atomic_load(p, __ATOMIC_RELAXED, __HIP_MEMORY_SCOPE_AGENT); }
__device__ __forceinline__ unsigned xb_add(unsigned* p, unsigned v) { return __hip_atomic_fetch_add(p, v, __ATOMIC_RELAXED, __HIP_MEMORY_SCOPE_AGENT); }
__device__ __forceinline__ unsigned xb_xcc_id() { return (unsigned)__builtin_amdgcn_s_getreg((3 << 11) | 20) & 0xFu; }
#define XB_SPIN(cond, bar) do { unsigned _sp = 0; while (cond) { __builtin_amdgcn_s_sleep(1); \
    if ((++_sp & 255u) == 0u) { if (xb_ld(&(bar)[XB_TMO])) break; if (_sp > XB_SPIN_CAP) { atomicAdd(&(bar)[XB_TMO], 1u); break; } } } } while (0)

struct XcdBarrier {
    unsigned* bar; unsigned x;
    volatile LAS unsigned* st;
};

__device__ __forceinline__ XcdBarrier xcd_barrier_post(unsigned* bar, volatile LAS unsigned* st) {
    XcdBarrier b; b.bar = bar; b.x = xb_xcc_id(); b.st = st;
    if (threadIdx.x == 0) (void)xb_add(&bar[XB_XCNT(b.x)], 1u);
    return b;
}
__device__ __forceinline__ void xcd_barrier_complete(unsigned* bar, unsigned x, unsigned& nloc, unsigned& nx) {
    const unsigned G = gridDim.x * gridDim.y * gridDim.z;
    unsigned sum, cnt, mine, sp = 0u;
    for (;;) {
        sum = 0u; cnt = 0u; mine = 0u;
#pragma unroll
        for (unsigned j = 0; j < 16; ++j) { const unsigned c = xb_ld(&bar[XB_XCNT(j)]); sum += c; cnt += (c > 0u) ? 1u : 0u; mine = (j == x) ? c : mine; }
        if (sum == G) break;
        __builtin_amdgcn_s_sleep(1);
        if ((++sp & 255u) == 0u) { if (xb_ld(&bar[XB_TMO])) break; if (sp > XB_SPIN_CAP) { atomicAdd(&bar[XB_TMO], 1u); break; } }
    }
    nloc = mine > 0u ? mine : 1u; nx = cnt > 0u ? cnt : 1u;
}

__device__ __forceinline__ void xcd_barrier(const XcdBarrier& b) {
    asm volatile("s_waitcnt vmcnt(0)" ::: "memory");
    __syncthreads();
    if (threadIdx.x == 0) {
        unsigned* bar = b.bar;
        __builtin_amdgcn_s_waitcnt(0);
        unsigned nloc = b.st[0], nx = b.st[1];
        if (nloc == 0u) { xcd_barrier_complete(bar, b.x, nloc, nx); b.st[0] = nloc; b.st[1] = nx; }
        const unsigned old = xb_add(&bar[XB_XSUB(b.x)], 1u);
        const unsigned gen = old / nloc;
        if (old + 1u == (gen + 1u) * nloc) {
            __builtin_amdgcn_fence(__ATOMIC_RELEASE, "agent");
            asm volatile("s_waitcnt vmcnt(0)" ::: "memory");
            const unsigned og = xb_add(&bar[XB_TOP], 1u);
            const unsigned tg = og / nx;
            if (og + 1u == (tg + 1u) * nx) xb_add(&bar[XB_TOPGEN], 1u);
            else XB_SPIN(xb_ld(&bar[XB_TOPGEN]) == tg, bar);
            __builtin_amdgcn_fence(__ATOMIC_ACQUIRE, "agent");
            xb_add(&bar[XB_XGEN(b.x)], 1u);
            asm volatile("s_waitcnt vmcnt(0)" ::: "memory");
        } else {
            XB_SPIN(xb_ld(&bar[XB_XGEN(b.x)]) == gen, bar);
            __builtin_amdgcn_fence(__ATOMIC_ACQUIRE, "agent");
            asm volatile("s_waitcnt vmcnt(0)" ::: "memory");
        }
    }
    __syncthreads();
}

struct Frame {
    LAS unsigned char* lds;
    volatile LAS unsigned* MISC;
    gu32* ctl;
    int wave, vcu, G;
};
struct Args { const float* in[15]; float* out; unsigned char* ws; int ph_lo, ph_hi, chunk, pad; };
#define P_xp (A.in[0])
#define P_xs (A.in[1])
#define P_w_in (A.in[2])
#define P_b_gates (A.in[3])
#define P_mh_norm_w (A.in[4])
#define P_q_norm_w (A.in[5])
#define P_k_norm_w (A.in[6])
#define P_w_out (A.in[7])
#define P_norm1_w (A.in[8])
#define P_norm2_w (A.in[9])
#define P_w_up (A.in[10])
#define P_conv_w (A.in[11])
#define P_conv_b (A.in[12])
#define P_w_down (A.in[13])
#define P_final_norm_w (A.in[14])
#define P_out (A.out)
#define P_WIN ((bf16*)(A.ws + WS_WIN))
#define P_WOUT ((bf16*)(A.ws + WS_WOUT))
#define P_WUP ((bf16*)(A.ws + WS_WUP))
#define P_WDN ((bf16*)(A.ws + WS_WDN))
#define P_KV ((bf16*)(A.ws + WS_KV))
#define P_XN ((bf16*)(A.ws + WS_XN))
#define P_MIX ((bf16*)(A.ws + WS_MIX))
#define P_MK ((bf16*)(A.ws + WS_MK))
#define P_MV ((bf16*)(A.ws + WS_MV))
#define P_MO ((bf16*)(A.ws + WS_MO))
#define P_HALO ((float*)(A.ws + WS_HALO))
#define P_ACT ((bf16*)(A.ws + WS_ACT))
#define P_ROPE ((float*)(A.ws + WS_ROPE))
#define P_PART1 ((float*)(A.ws + WS_PART1))
#define P_PART2 ((float*)(A.ws + WS_PART2))
#define P_GT ((float*)(A.ws + WS_G))
#define P_HF ((float*)(A.ws + WS_HF))
__device__ __constant__ float ROPE_INV[16] = {1.0f, 0.5623413251903491f, 0.31622776601683794f, 0.1778279410038923f, 0.1f, 0.05623413251903491f, 0.03162277660168379f, 0.01778279410038923f,
                                              0.01f, 0.005623413251903491f, 0.003162277660168379f, 0.001778279410038923f, 0.001f, 0.0005623413251903491f, 0.00031622776601683794f, 0.0001778279410038923f};
constexpr float C2Q = 0.125f * 1.4426950408889634f;

__device__ __forceinline__ float wave_sum(float v) {
#pragma unroll
    for (int o = 1; o < 64; o <<= 1) v += __shfl_xor(v, o);
    return v;
}
__device__ __forceinline__ void transpose_item(const float* src, int sstride, const float* kscale, bf16* dst, int dpitch, int k0, LAS float* scr, int lane) {
#pragma unroll 8
    for (int i = 0; i < 32; ++i) { const int kk = 2 * i + (lane >> 5); float v = src[(size_t)(k0 + kk) * sstride + (lane & 31)]; if (kscale) v *= kscale[k0 + kk]; scr[kk * 33 + (lane & 31)] = v; }
    LDS_WAIT(); asm volatile("" ::: "memory");
    const int c = lane & 7;
#pragma unroll
    for (int j = 0; j < 4; ++j) { const int n = (lane >> 3) + 8 * j; const LAS float* s = scr + (8 * c) * 33 + n;
        v4u o; o.x = pk2(s[0 * 33], s[1 * 33]); o.y = pk2(s[2 * 33], s[3 * 33]); o.z = pk2(s[4 * 33], s[5 * 33]); o.w = pk2(s[6 * 33], s[7 * 33]);
        *(GAS v4u*)(dst + (size_t)n * dpitch + k0 + 8 * c) = o; }
    LDS_WAIT(); asm volatile("" ::: "memory");
}
__device__ __forceinline__ void rope_entry(float* ROPE, int e) {
    const int idx = e >> 4, i = e & 15; const int pos = idx < 256 ? idx : idx - 256;
    const float ang = (float)pos * ROPE_INV[i];
    const double TWO_PI = 6.283185307179586476925;
    const double a = (double)ang, k = rint(a * (1.0 / TWO_PI)), r = a - k * TWO_PI;
    const double x = r * 0.25, x2 = x * x;
    const double s = x * (1.0 + x2 * (-1.0 / 6 + x2 * (1.0 / 120 + x2 * (-1.0 / 5040 + x2 * (1.0 / 362880 + x2 * (-1.0 / 39916800 + x2 * (1.0 / 6227020800.0)))))));
    const double c = 1.0 + x2 * (-0.5 + x2 * (1.0 / 24 + x2 * (-1.0 / 720 + x2 * (1.0 / 40320 + x2 * (-1.0 / 3628800 + x2 * (1.0 / 479001600.0 + x2 * (-1.0 / 87178291200.0)))))));
    const double s2 = 2 * s * c, c2 = 1 - 2 * s * s, s4 = 2 * s2 * c2, c4 = 1 - 2 * s2 * s2;
    ROPE[2 * e] = (float)c4; ROPE[2 * e + 1] = (float)s4;
}
__device__ __forceinline__ void rms_row_to_bf16(const float* xrow, const float* w, bf16* orow, int lane) {
    const GAS f32x4* xr = (const GAS f32x4*)xrow + lane; const GAS f32x4* wr = (const GAS f32x4*)w + lane;
    f32x4 v[4]; float s = 0.f;
#pragma unroll
    for (int j = 0; j < 4; ++j) { v[j] = xr[64 * j]; s += (v[j].x * v[j].x + v[j].y * v[j].y) + (v[j].z * v[j].z + v[j].w * v[j].w); }
    const float rinv = 1.f / sqrtf(wave_sum(s) * (1.f / DM) + EPS);
    GAS unsigned long long* o8 = (GAS unsigned long long*)orow + lane;
#pragma unroll
    for (int j = 0; j < 4; ++j) { const f32x4 ww = wr[64 * j];
        o8[64 * j] = (unsigned long long)pk2(v[j].x * rinv * ww.x, v[j].y * rinv * ww.y) | ((unsigned long long)pk2(v[j].z * rinv * ww.z, v[j].w * rinv * ww.w) << 32); }
}
__device__ __forceinline__ void p0_prologue(Frame& F, const Args& A) {
    LAS float* scr = (LAS float*)(F.lds + RING_OFF + F.wave * 16384);
    const int gw = F.vcu * NWAVES + F.wave, NGW = F.G * NWAVES;
    constexpr int I_IN = 16 * 89, I_OUT = 16 * 32, I_UP = 16 * 176, I_DN = 44 * 32, NITEMS = I_IN + I_OUT + I_UP + I_DN;
    for (int it = gw; it < NITEMS; it += NGW) {
        int r = it;
        if (r < I_IN) { const int kb = r / 89, d0 = 32 * (r % 89);
            const int sc = d0 < 2048 ? d0 : d0 < 2560 ? 2080 + (d0 - 2048) : d0 < 2816 ? 2592 + (d0 - 2560) : 2048 + (d0 - 2816);
            transpose_item(P_w_in + sc, INC, nullptr, P_WIN + (size_t)d0 * DM, DM, 64 * kb, scr, ((int)threadIdx.x & 63)); continue; } r -= I_IN;
        if (r < I_OUT) { const int kb = r / 32, d0 = 32 * (r % 32); transpose_item(P_w_out + d0, DM, nullptr, P_WOUT + (size_t)d0 * DM, DM, 64 * kb, scr, ((int)threadIdx.x & 63)); continue; } r -= I_OUT;
        if (r < I_UP) { const int kb = r / 176, nb = r % 176, tile = nb >> 3, wi = nb & 7; const int sc = wi < 4 ? 128 * tile + 32 * wi : FF + 128 * tile + 32 * (wi - 4);
            transpose_item(P_w_up + sc, FF2, P_norm2_w, P_WUP + (size_t)(32 * nb) * DM, DM, 64 * kb, scr, ((int)threadIdx.x & 63)); continue; } r -= I_UP;
        { const int kb = r / 32, d0 = 32 * (r % 32); transpose_item(P_w_down + d0, DM, nullptr, P_WDN + (size_t)d0 * FF, FF, 64 * kb, scr, ((int)threadIdx.x & 63)); }
    }
    const int gt = gw * 64 + ((int)threadIdx.x & 63), NTH = NGW * 64;
    for (int i = gt; i < (INP - INC) * DM / 8; i += NTH) ((GAS v4u*)(P_WIN + (size_t)INC * DM))[i] = (v4u){0u, 0u, 0u, 0u};
    for (int e = gt; e < 320 * 16; e += NTH) rope_entry(P_ROPE, e);
    for (int m = gw; m < M; m += NGW) rms_row_to_bf16(m < T0 ? P_xp + (size_t)m * DM : P_xs + (size_t)(m - T0) * DM, P_norm1_w, P_XN + (size_t)m * DM, ((int)threadIdx.x & 63));
}
__device__ __forceinline__ void rope8(v4u& w, const float* nw, const float* cs, const float* sn, bool second, float outscale) {
    float x[8] = {bflo(w.x), bfhi(w.x), bflo(w.y), bfhi(w.y), bflo(w.z), bfhi(w.z), bflo(w.w), bfhi(w.w)};
    float ss = 0.f;
#pragma unroll
    for (int j = 0; j < 8; ++j) ss += x[j] * x[j];
    ss += __shfl_xor(ss, 1); ss += __shfl_xor(ss, 2); ss += __shfl_xor(ss, 4);
    const float rinv = 1.f / sqrtf(ss * (1.f / 64.f) + EPS);
    float o[8];
#pragma unroll
    for (int j = 0; j < 8; ++j) { const float y = x[j] * rinv * nw[j]; const float p = __shfl_xor(y, 2); o[j] = (second ? y * cs[j] + p * sn[j] : y * cs[j] - p * sn[j]) * outscale; }
    w.x = pk2(o[0], o[1]); w.y = pk2(o[2], o[3]); w.z = pk2(o[4], o[5]); w.w = pk2(o[6], o[7]);
}
__device__ __forceinline__ void p2_rope(Frame& F, const Args& A) {
    const int gw = F.vcu * NWAVES + F.wave, NGW = F.G * NWAVES, lane = ((int)threadIdx.x & 63);
    const int sub = lane & 7; const bool second = (sub & 2) != 0, colpart = sub >= 4; const int i0 = 8 * (sub & 1);
    float qw[8], kw[8];
#pragma unroll
    for (int j = 0; j < 8; ++j) { qw[j] = P_q_norm_w[8 * sub + j]; kw[j] = P_k_norm_w[8 * sub + j]; }
    for (int m = gw; m < M; m += NGW) {
        const int t = m < T0 ? m : ((m - T0) & (T1 - 1));
        const int tidx = colpart ? 256 + (t & 63) : (t >> 6);
        const GAS f32x4* tab = (const GAS f32x4*)(P_ROPE + (size_t)(tidx * 16 + i0) * 2);
        float cs[8], sn[8];
#pragma unroll
        for (int j = 0; j < 4; ++j) { const f32x4 v = tab[j]; cs[2 * j] = v.x; sn[2 * j] = v.y; cs[2 * j + 1] = v.z; sn[2 * j + 1] = v.w; }
        { GAS v4u* p = (GAS v4u*)(P_MIX + (size_t)m * DM + 512) + lane; v4u w = *p; rope8(w, qw, cs, sn, second, C2Q); *p = w; }
        if (lane < 16) { GAS v4u* p = (GAS v4u*)(P_KV + (size_t)m * 256) + lane; v4u w = *p; rope8(w, kw, cs, sn, second, 1.0f); *p = w; }
    }
}
__device__ __forceinline__ void p3_mlstm_naive(Frame& F, const Args& A) {
    LAS float* red = (LAS float*)(F.lds);
    LAS float* dred = red + 1024;
    const int tid = ((int)threadIdx.x), dv = tid & 63, dkg = F.wave;
    for (int item = blockIdx.x; item < 17 * 8; item += F.G) {
        const int seq = item >> 3, h = item & 7;
        const int T = seq == 0 ? T0 : T1; const long rowbase = seq == 0 ? 0 : T0 + (long)(seq - 1) * T1;
        const float mhw = P_mh_norm_w[h * 64 + dv];
        for (int dir = 0; dir < 2; ++dir) {
            float C[8], nn[8]; float m = 0.f;
#pragma unroll
            for (int i = 0; i < 8; ++i) { C[i] = 0.f; nn[i] = 0.f; }
            const int gi = dir * 8 + h, gf = 16 + dir * 8 + h;
            long row = rowbase + (dir ? T - 1 : 0);
            v4u kw = *(const GAS v4u*)(P_MK + row * 512 + h * 64 + dkg * 8), qw = *(const GAS v4u*)(P_MIX + row * DM + h * 64 + dkg * 8);
            unsigned short vv = P_MV[row * 512 + h * 64 + dv]; float ig = P_GT[row * 32 + gi], fg = P_GT[row * 32 + gf];
            for (int step = 0; step < T; ++step) {
                const long rowc = row; const v4u kc = kw, qc = qw; const float vc = bf2f(vv), igc = ig, fgc = fg;
                if (step + 1 < T) { row = rowbase + (dir ? T - 2 - step : step + 1);
                    kw = *(const GAS v4u*)(P_MK + row * 512 + h * 64 + dkg * 8); qw = *(const GAS v4u*)(P_MIX + row * DM + h * 64 + dkg * 8);
                    vv = P_MV[row * 512 + h * 64 + dv]; ig = P_GT[row * 32 + gi]; fg = P_GT[row * 32 + gf]; }
                const float logf = fgc < 0.f ? fgc - log1pf(expf(fgc)) : -log1pf(expf(-fgc));
                const float m_new = fmaxf(logf + m, igc), a = expf(logf + m - m_new), b = expf(igc - m_new); m = m_new;
                const float k[8] = {bflo(kc.x), bfhi(kc.x), bflo(kc.y), bfhi(kc.y), bflo(kc.z), bfhi(kc.z), bflo(kc.w), bfhi(kc.w)};
                const float q[8] = {bflo(qc.x), bfhi(qc.x), bflo(qc.y), bfhi(qc.y), bflo(qc.z), bfhi(qc.z), bflo(qc.w), bfhi(qc.w)};
                float pn = 0.f, pd = 0.f;
#pragma unroll
                for (int i = 0; i < 8; ++i) { const float bk = b * k[i]; C[i] = a * C[i] + bk * vc; nn[i] = a * nn[i] + bk; pn += q[i] * C[i]; pd += q[i] * nn[i]; }
                const int buf = step & 1; red[buf * 512 + dkg * 64 + dv] = pn; if (dv == 0) dred[buf * 8 + dkg] = pd;
                __syncthreads();
                if (tid < 64) {
                    float num = 0.f, den = 0.f;
#pragma unroll
                    for (int g = 0; g < 8; ++g) { num += red[buf * 512 + g * 64 + dv]; den += dred[buf * 8 + g]; }
                    const float hval = num / fmaxf(fabsf(den), expf(-m));
                    if (dir == 0) P_HF[rowc * 512 + h * 64 + dv] = hval;
                    else { const float hs = hval + P_HF[rowc * 512 + h * 64 + dv]; const float ss = wave_sum(hs * hs);
                        const float y = hs / sqrtf(ss * (1.f / 64.f) + EPS) * mhw; const float mo = bf2f(P_MO[rowc * 512 + h * 64 + dv]);
                        P_MIX[rowc * DM + h * 64 + dv] = (bf16)f2bf(y / (1.f + expf(-mo))); }
                }
            }
            __syncthreads();
        }
    }
}
__device__ __forceinline__ void unpack8(const v4u w, float* x) { x[0] = bflo(w.x); x[1] = bfhi(w.x); x[2] = bflo(w.y); x[3] = bfhi(w.y); x[4] = bflo(w.z); x[5] = bfhi(w.z); x[6] = bflo(w.w); x[7] = bfhi(w.w); }
__device__ __forceinline__ void conv_fixup(Frame& F, const Args& A) {
    const int gt = (F.vcu * NWAVES + F.wave) * 64 + ((int)threadIdx.x & 63), NTH = F.G * NWAVES * 64;
    const float* H = P_HALO;
    for (int ti = gt; ti < 384 * 352; ti += NTH) {
        const int cg = ti % 352, rr = ti / 352, pm = rr >> 1, e = rr & 1, j0 = 8 * cg;
        const bool seq_start = (pm == 0) || (pm >= 64 && ((pm - 64) & 7) == 0), seq_end = (pm == 63) || (pm >= 64 && ((pm - 64) & 7) == 7);
        float cv[2][8];
#pragma unroll
        for (int bj = 0; bj < 2; ++bj) {
#define HROW(p, ee) (H + (((size_t)(p) * 4 + (ee)) * 2 + bj) * FF + j0)
            const float* pr = e == 0 ? (seq_start ? nullptr : HROW(pm - 1, 3)) : HROW(pm, 2);
            const float* cu = e == 0 ? HROW(pm, 0) : HROW(pm, 3);
            const float* nx = e == 0 ? HROW(pm, 1) : (seq_end ? nullptr : HROW(pm + 1, 0));
#undef HROW
#pragma unroll
            for (int j = 0; j < 8; ++j) { const int col = bj * FF + j0 + j;
                cv[bj][j] = P_conv_w[col] * (pr ? pr[j] : 0.f) + P_conv_w[FF2 + col] * cu[j] + P_conv_w[2 * FF2 + col] * (nx ? nx[j] : 0.f) + P_conv_b[col]; }
        }
        float o[8];
#pragma unroll
        for (int j = 0; j < 8; ++j) o[j] = cv[0][j] * cv[1][j] / (1.f + __expf(-cv[1][j]));
        v4u w; w.x = pk2(o[0], o[1]); w.y = pk2(o[2], o[3]); w.z = pk2(o[4], o[5]); w.w = pk2(o[6], o[7]);
        *(GAS v4u*)(P_ACT + (size_t)(256 * pm + (e ? 255 : 0)) * FF + j0) = w;
    }
}
__device__ __forceinline__ void p4_attn_naive(Frame& F, const Args& A) {
    LAS bf16* Ks = (LAS bf16*)F.lds; LAS bf16* Vs = Ks + 4096; LAS float* red = (LAS float*)(F.lds + 16384);
    const int tid = ((int)threadIdx.x), qi = tid & 63, part = F.wave;
    for (int item = blockIdx.x; item < (M / 64) * 8; item += F.G) {
        const int h = item & 7, rb = item >> 3; const long row0 = (long)rb * 64;
        const long seqbase = row0 < T0 ? 0 : T0 + ((row0 - T0) / T1) * T1; const int NT = row0 < T0 ? T0 / 64 : T1 / 64;
        float q[64], o[64]; float l = 0.f;
        { const GAS v4u* qp = (const GAS v4u*)(P_MIX + (row0 + qi) * DM + 512 + h * 64);
#pragma unroll
          for (int c = 0; c < 8; ++c) { float t[8]; unpack8(qp[c], t);
#pragma unroll
              for (int j = 0; j < 8; ++j) { q[8 * c + j] = t[j]; o[8 * c + j] = 0.f; } } }
        const int kvh = h >> 2;
        for (int kt = 0; kt < NT; ++kt) {
            __syncthreads();
            { const long kr = seqbase + (long)kt * 64 + (tid >> 3); const int ch = tid & 7;
              *(LAS v4u*)(Ks + (tid >> 3) * 64 + ch * 8) = *(const GAS v4u*)(P_KV + kr * 256 + kvh * 64 + ch * 8);
              *(LAS v4u*)(Vs + (tid >> 3) * 64 + ch * 8) = *(const GAS v4u*)(P_KV + kr * 256 + 128 + kvh * 64 + ch * 8); }
            __syncthreads();
            for (int kk = 0; kk < 8; ++kk) { const int key = part * 8 + kk; float s = 0.f;
#pragma unroll
                for (int c = 0; c < 8; ++c) { float t[8]; unpack8(*(const LAS v4u*)(Ks + key * 64 + c * 8), t);
#pragma unroll
                    for (int j = 0; j < 8; ++j) s += q[8 * c + j] * t[j]; }
                const float pw = exp2f(s); l += pw;
#pragma unroll
                for (int c = 0; c < 8; ++c) { float t[8]; unpack8(*(const LAS v4u*)(Vs + key * 64 + c * 8), t);
#pragma unroll
                    for (int j = 0; j < 8; ++j) o[8 * c + j] += pw * t[j]; } }
        }
        for (int pp = 1; pp < 8; ++pp) {
            __syncthreads();
            if (part == pp) {
#pragma unroll
                for (int d = 0; d < 64; ++d) red[qi * 66 + d] = o[d];
                red[qi * 66 + 64] = l; }
            __syncthreads();
            if (part == 0) {
#pragma unroll
                for (int d = 0; d < 64; ++d) o[d] += red[qi * 66 + d];
                l += red[qi * 66 + 64]; }
        }
        if (part == 0) { const float rl = 1.f / l; GAS v4u* op = (GAS v4u*)(P_MIX + (row0 + qi) * DM + 512 + h * 64);
#pragma unroll
            for (int c = 0; c < 8; ++c) { v4u w; w.x = pk2(o[8 * c] * rl, o[8 * c + 1] * rl); w.y = pk2(o[8 * c + 2] * rl, o[8 * c + 3] * rl); w.z = pk2(o[8 * c + 4] * rl, o[8 * c + 5] * rl); w.w = pk2(o[8 * c + 6] * rl, o[8 * c + 7] * rl); op[c] = w; } }
        __syncthreads();
    }
}
__device__ __forceinline__ void final_norm(Frame& F, const Args& A) {
    const int gw = F.vcu * NWAVES + F.wave, NGW = F.G * NWAVES, lane = ((int)threadIdx.x & 63);
    for (int m = gw; m < M; m += NGW) {
        const float ss = wave_sum(lane < 16 ? P_PART2[(size_t)m * 16 + lane] : 0.f);
        const float rinv = 1.f / sqrtf(ss * (1.f / DM) + EPS);
        GAS f32x4* row = (GAS f32x4*)(P_out + (size_t)m * DM) + lane; const GAS f32x4* wr = (const GAS f32x4*)P_final_norm_w + lane;
#pragma unroll
        for (int j = 0; j < 4; ++j) { const f32x4 v = row[64 * j], w = wr[64 * j]; row[64 * j] = v * rinv * w; }
    }
}

#ifndef MK_FUSED
#define MK_FUSED 0
#endif
constexpr int NPH = 10;
__global__ void __launch_bounds__(NWAVES * 64, 2) enc_fwd(Args args) {
    extern __shared__ __attribute__((aligned(16))) unsigned char lds[];
    Frame F;
    F.lds = (LAS unsigned char*)lds;
    F.MISC = (volatile LAS unsigned*)(F.lds + MISC_OFF);
    F.wave = __builtin_amdgcn_readfirstlane((int)threadIdx.x >> 6);
    F.G = gridDim.x; { const int bx = blockIdx.x; F.vcu = (F.G % 8 == 0) ? (bx % 8) * (F.G / 8) + bx / 8 : bx; }
    const Args& A = args;
    F.ctl = (gu32*)(args.ws + WS_CTL);
    for (int u = ((int)threadIdx.x); u < (LDS_BYTES - LDSCTL_OFF) / 4; u += NWAVES * 64) ((LAS unsigned*)(F.lds + LDSCTL_OFF))[u] = 0u;
    __syncthreads();
    const int lo = args.ph_lo, hi = args.ph_hi;
    XcdBarrier bar; bar.bar = (unsigned*)(F.ctl + CW_BAR); bar.x = 0; bar.st = nullptr;
    if (hi - lo > 1) bar = xcd_barrier_post((unsigned*)(F.ctl + CW_BAR), F.MISC + 8);
#ifndef PHMASK
#define PHMASK 0xffff
#endif
#define IN(k) (((PHMASK >> (k)) & 1) && lo <= (k) && (k) < hi)
#define SEAM(k) do { if (IN(k) && IN((k) + 1)) xcd_barrier(bar); } while (0)

    if (IN(0)) { p0_prologue(F, A); SEAM(0); }
    if (IN(1)) {
        pg8::Gemm g{P_XN, P_WIN, M, INP, DM}; pg8::StaticOrder S; S.init(M, INP, F.G, (int)blockIdx.x);
        pg8::EpiIn E{P_MIX, P_MK, P_MV, P_MO, P_KV, P_GT, P_b_gates};
        pg8::gemm_phase<pg8::EpiIn, pg8::StaticOrder, true, true>(F.lds + RING_OFF, g, S, E);
        SEAM(1);
    }
#ifndef MLSTM_NAIVE
#define MLSTM_NAIVE 0
#endif
    if (IN(2)) { p2_rope(F, A);
        if (!MLSTM_NAIVE) for (int item = blockIdx.x; item < attn_body::mls::NITEM; item += F.G)
            attn_body::mls::m1_item(item, (const attn_body::bf16*)P_MK, (const attn_body::bf16*)P_MV, P_GT, P_HF, (char*)lds);
        SEAM(2); }
    if (IN(3)) { if (MLSTM_NAIVE) p3_mlstm_naive(F, A); else attn_body::mls::m2_scan(P_HF, (F.vcu * NWAVES + F.wave) * 64 + ((int)threadIdx.x & 63), F.G * NWAVES * 64); SEAM(3); }
#ifndef ATTN_NAIVE
#define ATTN_NAIVE 0
#endif
    if (IN(4) && ATTN_NAIVE) { p4_attn_naive(F, A); SEAM(4); }
    if (IN(4) && !ATTN_NAIVE) {
        const attn_body::UnitOrder S((int)F.G, F.vcu);
        attn_body::attn_phase<8>((char*)lds + RING_OFF, (const attn_body::bf16*)P_MIX, (const attn_body::bf16*)P_KV, (attn_body::bf16*)P_MIX, S);
        if (!MLSTM_NAIVE) for (int item = blockIdx.x; item < attn_body::mls::NITEM; item += F.G)
            attn_body::mls::m3_item(item, (const attn_body::bf16*)P_MIX, (const attn_body::bf16*)P_MK, (const attn_body::bf16*)P_MV, (const attn_body::bf16*)P_MO, P_GT, P_HF, P_mh_norm_w, (attn_body::bf16*)P_MIX, (char*)lds);
        SEAM(4);
    }
    if (IN(5)) {
        pg8::Gemm g{P_MIX, P_WOUT, M, DM, DM}; pg8::StaticOrder S; S.init(M, DM, F.G, (int)blockIdx.x);
        pg8::EpiRes<true> E{P_xp, P_xs, P_out, P_XN, P_PART1, 0};
        pg8::gemm_phase<pg8::EpiRes<true>, pg8::StaticOrder, true, true>(F.lds + RING_OFF, g, S, E);
        SEAM(5);
    }
    if (IN(6)) {
        pg8::Gemm g{P_XN, P_WUP, M, FF2, DM}; pg8::StaticOrder S; S.init(M, FF2, F.G, (int)blockIdx.x);
        pg8::EpiUpConv E{P_ACT, P_PART1, P_conv_w, P_conv_b, P_HALO, (PG8_LAS float*)(F.lds + EX_OFF)};
        pg8::gemm_phase<pg8::EpiUpConv, pg8::StaticOrder, true, true>(F.lds + RING_OFF, g, S, E);
        SEAM(6);
    }
    if (IN(7)) { conv_fixup(F, A); SEAM(7); }
    if (IN(8)) {
        pg8::Gemm g{P_ACT, P_WDN, M, DM, FF}; pg8::StaticOrder S; S.init(M, DM, F.G, (int)blockIdx.x);
        pg8::EpiRes<false> E{P_out, P_out + (size_t)T0 * DM, P_out, nullptr, P_PART2, 0};
        pg8::gemm_phase<pg8::EpiRes<false>, pg8::StaticOrder, true, true>(F.lds + RING_OFF, g, S, E);
        SEAM(8);
    }
    if (IN(9)) final_norm(F, A);
#undef IN
#undef SEAM
}

extern "C" void kernel_launch(void* const* d_in, const int* in_sizes, int n_in, void* d_out, int out_size, void* d_ws, size_t ws_size, hipStream_t stream) {
    static int grid = 0;
    if (grid == 0) {
        if (n_in != 15 || in_sizes[0] != T0 * DM || in_sizes[1] != NSEQ1 * T1 * DM || out_size != M * DM || ws_size < WS_END) {
            fprintf(stderr, "kernel_launch: unexpected shapes (n_in %d, in0 %d, out %d, ws %zu); nothing launched\n", n_in, n_in > 0 ? in_sizes[0] : -1, out_size, ws_size); grid = -1; return; }
        int dev = 0, cus = 0, per_cu = 0;
        if (hipGetDevice(&dev) != hipSuccess || hipDeviceGetAttribute(&cus, hipDeviceAttributeMultiprocessorCount, dev) != hipSuccess) { grid = -1; return; }
        if (hipFuncSetAttribute((const void*)enc_fwd, hipFuncAttributeMaxDynamicSharedMemorySize, LDS_BYTES) != hipSuccess) { fprintf(stderr, "kernel_launch: hipFuncSetAttribute failed\n"); grid = -1; return; }
        if (hipOccupancyMaxActiveBlocksPerMultiprocessor(&per_cu, (const void*)enc_fwd, NWAVES * 64, LDS_BYTES) != hipSuccess || per_cu < 1)
            fprintf(stderr, "kernel_launch: note: occupancy query reports %d workgroups per CU\n", per_cu);
        (void)hipGetLastError();
        grid = cus;
    }
    if (grid < 0) return;
    if (hipMemsetAsync((char*)d_ws + WS_CTL, 0, CTL_ZERO_BYTES, stream) != hipSuccess) { fprintf(stderr, "kernel_launch: hipMemsetAsync failed\n"); return; }
    Args a{};
    for (int i = 0; i < 15; ++i) a.in[i] = (const float*)d_in[i];
    a.out = (float*)d_out; a.ws = (unsigned char*)d_ws;
#if MK_FUSED
    a.ph_lo = 0; a.ph_hi = NPH;
    hipLaunchKernelGGL(enc_fwd, dim3(grid), dim3(NWAVES * 64), LDS_BYTES, stream, a);
#else
    for (int ph = 0; ph < NPH; ++ph) { a.ph_lo = ph; a.ph_hi = ph + 1; hipLaunchKernelGGL(enc_fwd, dim3(grid), dim3(NWAVES * 64), LDS_BYTES, stream, a); }
#endif
    const hipError_t le = hipPeekAtLastError();
    if (le != hipSuccess) fprintf(stderr, "kernel_launch: launch failed: %s\n", hipGetErrorName(le));
}
```
